# Optimizing an MI355X kernel written in HIP

```python
import math
import jax, jax.numpy as jnp
from jax import lax
import numpy as np

D_MODEL = 1024
BATCH = 8
SEQ = 2048
DEPTH = 1
DEC_BATCH = 128
DEC_SEQ = 1
PAST_LEN = 16384
PAGE_SIZE = 128

D_MIX = 2 * D_MODEL
HGRN_HEADS = 8
HGRN_DK = 128
HGRN_DV = 128
D_HGRN = HGRN_HEADS * HGRN_DV
HGRN_CHUNK = 64
SSM_HEADS = 16
SSM_HEAD_DIM = 64
D_SSM = SSM_HEADS * SSM_HEAD_DIM
SSM_STATE = 128
SSM_GROUPS = 2
SSM_CONV = 4
SSM_CHUNK = 128
CONV_DIM = D_SSM + 2 * SSM_GROUPS * SSM_STATE
DT_MIN = 0.001
DT_MAX = 0.1
D_FF = 2816
FFN_CONV = 3
EPS = 1e-6
IN_SIZES = (HGRN_HEADS * HGRN_DK, HGRN_HEADS * HGRN_DK, D_HGRN, D_HGRN, D_SSM, CONV_DIM, SSM_HEADS)
D_IN = sum(IN_SIZES)

kernel_name = 'hymba_hgrn2_mamba2_convffn_step'


def _chunk_len(L, C):
    return C if L % C == 0 else L


def rmsnorm(x, w):
    xf = x.astype(jnp.float32)
    y = xf * lax.rsqrt(jnp.mean(xf * xf, axis=-1, keepdims=True) + EPS)
    return (y * w.astype(jnp.float32)).astype(x.dtype)


def causal_dwconv(x, buf, w, b):
    L = x.shape[1]
    xe = jnp.concatenate([buf.astype(x.dtype), x], axis=1)
    y = b.astype(x.dtype)
    for j in range(w.shape[0]):
        y = y + xe[:, j:j + L] * w[j].astype(x.dtype)
    return y, xe[:, L:]


def hgrn2_chunk(S, inp):
    q, k, v, g = inp
    C = q.shape[2]
    b = jnp.cumsum(g, axis=2)
    o = jnp.einsum('bhtk,bhkv->bhtv', q * jnp.exp(b), S)
    causal = jnp.tril(jnp.ones((C, C), dtype=bool))[:, :, None]
    diff = b[:, :, :, None, :] - b[:, :, None, :, :]
    decay = jnp.exp(jnp.where(causal, diff, -jnp.inf))
    A = jnp.einsum('bhtsk,bhsk->bhts', decay * q[:, :, :, None, :], k)
    o = o + jnp.einsum('bhts,bhsv->bhtv', A, v)
    b_last = b[:, :, -1:]
    S_new = jnp.exp(b_last[:, :, 0])[..., None] * S + jnp.einsum('bhsk,bhsv->bhkv', k * jnp.exp(b_last - b), v)
    return S_new, o


def hgrn2_mix(q, k, v, log_f, S0):
    Bsz, L, H, _ = q.shape
    C = _chunk_len(L, HGRN_CHUNK)
    nc = L // C

    def to_chunks(t):
        return t.reshape(Bsz, nc, C, H, t.shape[-1]).transpose(1, 0, 3, 2, 4)

    S_T, o = lax.scan(hgrn2_chunk, S0, (to_chunks(q), to_chunks(k), to_chunks(v), to_chunks(log_f)))
    o = o.transpose(1, 0, 3, 2, 4).reshape(Bsz, L, H, -1)
    return o, S_T


def segsum(x):
    T = x.shape[-1]
    cs = jnp.cumsum(x, axis=-1)
    d = cs[..., :, None] - cs[..., None, :]
    return jnp.where(jnp.tril(jnp.ones((T, T), dtype=bool)), d, -jnp.inf)


def ssd_scan(X, A, Bh, Ch, S0):
    Bsz, L, H, P = X.shape
    T = _chunk_len(L, SSM_CHUNK)
    nc = L // T
    X = X.reshape(Bsz, nc, T, H, P)
    Bh = Bh.reshape(Bsz, nc, T, H, -1)
    Ch = Ch.reshape(Bsz, nc, T, H, -1)
    A = A.reshape(Bsz, nc, T, H).transpose(0, 3, 1, 2)
    A_cs = jnp.cumsum(A, axis=-1)
    Lmat = jnp.exp(segsum(A))
    y_diag = jnp.einsum('bclhn,bcshn,bhcls,bcshp->bclhp', Ch, Bh, Lmat, X)
    decay_states = jnp.exp(A_cs[..., -1:] - A_cs)
    states = jnp.einsum('bclhn,bhcl,bclhp->bchpn', Bh, decay_states, X)
    states = jnp.concatenate([S0[:, None], states], axis=1)
    decay_chunk = jnp.exp(segsum(jnp.pad(A_cs[..., -1], ((0, 0), (0, 0), (1, 0)))))
    states = jnp.einsum('bhzc,bchpn->bzhpn', decay_chunk, states)
    y_off = jnp.einsum('bclhn,bchpn,bhcl->bclhp', Ch, states[:, :-1], jnp.exp(A_cs))
    y = (y_diag + y_off).reshape(Bsz, L, H, P)
    return y, states[:, -1]


def decoder_layer(x, S_h, S_s, buf_s, buf_f, lb, w):
    f32 = jnp.float32
    Bsz, L, _ = x.shape
    dt_ = x.dtype
    h = rmsnorm(x, w['norm1_w'])
    proj = h @ w['w_in']
    splits = np.cumsum(IN_SIZES)[:-1].tolist()
    q_r, f_r, i_r, g_r, z, xbc_r, dt_r = jnp.split(proj, splits, axis=-1)

    f = lb + (1.0 - lb) * jax.nn.sigmoid(f_r.astype(f32))
    log_f = jnp.log(f)
    k = 1.0 - f
    q = jax.nn.silu(q_r.astype(f32))

    def heads(t):
        return t.reshape(Bsz, L, HGRN_HEADS, -1)

    o_a, S_h_new = hgrn2_mix(heads(q), heads(k), heads(i_r.astype(f32)), heads(log_f), S_h.astype(f32))
    o_a = rmsnorm(o_a, w['hgrn_norm_w']) * jax.nn.silu(heads(g_r).astype(f32))
    o_a = o_a.reshape(Bsz, L, D_HGRN).astype(dt_)

    xbc, buf_s_new = causal_dwconv(xbc_r, buf_s, w['ssm_conv_w'], w['ssm_conv_b'])
    xbc = jax.nn.silu(xbc.astype(f32))
    xs, Bm, Cm = jnp.split(xbc, [D_SSM, D_SSM + SSM_GROUPS * SSM_STATE], axis=-1)
    dt = jax.nn.softplus(dt_r.astype(f32) + w['ssm_dt_bias'].astype(f32))
    A = -jnp.exp(w['ssm_a_log'].astype(f32))
    X = xs.reshape(Bsz, L, SSM_HEADS, SSM_HEAD_DIM)
    rep = SSM_HEADS // SSM_GROUPS
    Bh = jnp.repeat(Bm.reshape(Bsz, L, SSM_GROUPS, SSM_STATE), rep, axis=2)
    Ch = jnp.repeat(Cm.reshape(Bsz, L, SSM_GROUPS, SSM_STATE), rep, axis=2)
    y, S_s_new = ssd_scan(X * dt[..., None], A * dt, Bh, Ch, S_s.astype(f32))
    y = y + w['ssm_d'].astype(f32)[:, None] * X
    y = y.reshape(Bsz, L, D_SSM) * jax.nn.silu(z.astype(f32))
    y = rmsnorm(y.reshape(Bsz, L, SSM_GROUPS, -1), w['ssm_norm_w'].reshape(SSM_GROUPS, -1))
    y = y.reshape(Bsz, L, D_SSM).astype(dt_)

    x = x + jnp.concatenate([o_a, y], axis=-1) @ w['w_out']

    h = rmsnorm(x, w['norm2_w'])
    gate, val = jnp.split(h @ w['w_up'], 2, axis=-1)
    gate, buf_f_new = causal_dwconv(gate, buf_f, w['ffn_conv_w'], w['ffn_conv_b'])
    x = x + (jax.nn.silu(gate) * val) @ w['w_down']
    return (x, S_h_new.astype(S_h.dtype), S_s_new.astype(S_s.dtype),
            buf_s_new.astype(buf_s.dtype), buf_f_new.astype(buf_f.dtype))


def run_trunk(x, st_hgrn, st_ssm, st_cs, st_cf, hgrn_lb, layer_w, final_norm_w):
    lb_all = jnp.cumsum(jax.nn.softmax(hgrn_lb.astype(jnp.float32), axis=0), axis=0)
    new_h, new_s, new_cs, new_cf = [], [], [], []
    for l in range(DEPTH):
        w = {name: arr[l] for name, arr in layer_w.items()}
        x, sh, ss, scs, scf = decoder_layer(x, st_hgrn[l], st_ssm[l], st_cs[l], st_cf[l], lb_all[l], w)
        new_h.append(sh)
        new_s.append(ss)
        new_cs.append(scs)
        new_cf.append(scf)
    y = rmsnorm(x, final_norm_w)
    return y, jnp.stack(new_h), jnp.stack(new_s), jnp.stack(new_cs), jnp.stack(new_cf)


def setup_inputs(seed: int = 0) -> dict:
    key = jax.random.key(seed)
    k = jax.random.split(key, 24)
    f32 = jnp.float32

    def nrm(i, shape, scale):
        return jax.random.normal(k[i], shape, f32) * scale

    x_prompt = nrm(0, (BATCH, SEQ, D_MODEL), 1.0)
    x_sample = nrm(1, (DEC_BATCH, DEC_SEQ, D_MODEL), 1.0)
    state_hgrn = nrm(2, (DEPTH, DEC_BATCH, HGRN_HEADS, HGRN_DK, HGRN_DV), 0.5)
    state_ssm = nrm(3, (DEPTH, DEC_BATCH, SSM_HEADS, SSM_HEAD_DIM, SSM_STATE), 0.3)
    state_conv_ssm = nrm(4, (DEPTH, DEC_BATCH, SSM_CONV - 1, CONV_DIM), 1.0)
    state_conv_ffn = nrm(5, (DEPTH, DEC_BATCH, FFN_CONV - 1, D_FF), 1.0)
    norm1_w = 1.0 + nrm(6, (DEPTH, D_MODEL), 0.02)
    w_in = nrm(7, (DEPTH, D_MODEL, D_IN), D_MODEL ** -0.5)
    hgrn_lb = nrm(8, (DEPTH + 1, HGRN_HEADS * HGRN_DK), 0.1)
    hgrn_norm_w = 1.0 + nrm(9, (DEPTH, HGRN_DV), 0.02)
    ssm_conv_w = nrm(10, (DEPTH, SSM_CONV, CONV_DIM), SSM_CONV ** -0.5)
    ssm_conv_b = nrm(11, (DEPTH, CONV_DIM), 0.02)
    dt0 = jnp.exp(jax.random.uniform(k[12], (DEPTH, SSM_HEADS), f32, math.log(DT_MIN), math.log(DT_MAX)))
    ssm_dt_bias = dt0 + jnp.log(-jnp.expm1(-dt0))
    ssm_a_log = jnp.log(jax.random.uniform(k[13], (DEPTH, SSM_HEADS), f32, 1.0, 16.0))
    ssm_d = 1.0 + nrm(14, (DEPTH, SSM_HEADS), 0.02)
    ssm_norm_w = 1.0 + nrm(15, (DEPTH, D_SSM), 0.02)
    w_out = nrm(16, (DEPTH, D_MIX, D_MODEL), D_MIX ** -0.5)
    norm2_w = 1.0 + nrm(17, (DEPTH, D_MODEL), 0.02)
    w_up = nrm(18, (DEPTH, D_MODEL, 2 * D_FF), D_MODEL ** -0.5)
    ffn_conv_w = nrm(19, (DEPTH, FFN_CONV, D_FF), FFN_CONV ** -0.5)
    ffn_conv_b = nrm(20, (DEPTH, D_FF), 0.02)
    w_down = nrm(21, (DEPTH, D_FF, D_MODEL), D_FF ** -0.5)
    final_norm_w = 1.0 + nrm(22, (D_MODEL,), 0.02)
    return {'x_prompt': x_prompt, 'x_sample': x_sample,
            'state_hgrn': state_hgrn, 'state_ssm': state_ssm,
            'state_conv_ssm': state_conv_ssm, 'state_conv_ffn': state_conv_ffn,
            'norm1_w': norm1_w, 'w_in': w_in, 'hgrn_lb': hgrn_lb, 'hgrn_norm_w': hgrn_norm_w,
            'ssm_conv_w': ssm_conv_w, 'ssm_conv_b': ssm_conv_b, 'ssm_dt_bias': ssm_dt_bias,
            'ssm_a_log': ssm_a_log, 'ssm_d': ssm_d, 'ssm_norm_w': ssm_norm_w, 'w_out': w_out,
            'norm2_w': norm2_w, 'w_up': w_up, 'ffn_conv_w': ffn_conv_w, 'ffn_conv_b': ffn_conv_b,
            'w_down': w_down, 'final_norm_w': final_norm_w}


def reference(x_prompt, x_sample, state_hgrn, state_ssm, state_conv_ssm, state_conv_ffn,
              norm1_w, w_in, hgrn_lb, hgrn_norm_w, ssm_conv_w, ssm_conv_b, ssm_dt_bias,
              ssm_a_log, ssm_d, ssm_norm_w, w_out, norm2_w, w_up, ffn_conv_w, ffn_conv_b,
              w_down, final_norm_w):
    layer_w = {'norm1_w': norm1_w, 'w_in': w_in, 'hgrn_norm_w': hgrn_norm_w,
               'ssm_conv_w': ssm_conv_w, 'ssm_conv_b': ssm_conv_b, 'ssm_dt_bias': ssm_dt_bias,
               'ssm_a_log': ssm_a_log, 'ssm_d': ssm_d, 'ssm_norm_w': ssm_norm_w, 'w_out': w_out,
               'norm2_w': norm2_w, 'w_up': w_up, 'ffn_conv_w': ffn_conv_w, 'ffn_conv_b': ffn_conv_b,
               'w_down': w_down}
    bp = x_prompt.shape[0]
    dtp = x_prompt.dtype
    z_hgrn = jnp.zeros((DEPTH, bp, HGRN_HEADS, HGRN_DK, HGRN_DV), dtp)
    z_ssm = jnp.zeros((DEPTH, bp, SSM_HEADS, SSM_HEAD_DIM, SSM_STATE), dtp)
    z_cs = jnp.zeros((DEPTH, bp, SSM_CONV - 1, CONV_DIM), dtp)
    z_cf = jnp.zeros((DEPTH, bp, FFN_CONV - 1, D_FF), dtp)
    y_prompt, hgrn_p, ssm_p, cs_p, cf_p = run_trunk(
        x_prompt, z_hgrn, z_ssm, z_cs, z_cf, hgrn_lb, layer_w, final_norm_w)
    y_sample, hgrn_s, ssm_s, cs_s, cf_s = run_trunk(
        x_sample, state_hgrn, state_ssm, state_conv_ssm, state_conv_ffn, hgrn_lb, layer_w, final_norm_w)
    return (y_prompt, y_sample, hgrn_p, hgrn_s, ssm_p, ssm_s, cs_p, cs_s, cf_p, cf_s)
```

```cpp
#include <hip/hip_runtime.h>
#include <hip/hip_cooperative_groups.h>
#include <cstdio>
namespace cg = cooperative_groups;

#define DEV __device__ __forceinline__
#define PROBE_NOMIX 0
#define LAS __attribute__((address_space(3)))
typedef unsigned short bf16_t;
typedef short bf16x8 __attribute__((ext_vector_type(8)));
typedef float f32x4 __attribute__((ext_vector_type(4)));
typedef float f32x2 __attribute__((ext_vector_type(2)));
typedef unsigned u32x2 __attribute__((ext_vector_type(2)));
typedef unsigned u32x4 __attribute__((ext_vector_type(4)));

constexpr int NP = 16384, NSMP = 128, MV = NP + NSMP, MT = 16640;
constexpr int DM = 1024, DIN = 6672, DINP = 6912, DFF = 2816, LDP = 4608, LDM = 2048;
constexpr int SEQ = 2048, NB = 8;
constexpr float EPS = 1e-6f, LOG2E = 1.4426950408889634f, LN2 = 0.6931471805599453f;
constexpr int LDS_BYTES = 131072 + 8192;

constexpr size_t O_YP = 0, O_YS = 16777216, O_HP = 16908288, O_HS = 17956864, O_SP = 34734080, O_SS = 35782656,
                 O_CSP = 52559872, O_CSS = 52596736, O_CFP = 53186560, O_CFS = 53231616;
constexpr size_t W_OUT = 0, W_UP = W_OUT + (size_t)1024 * 2048 * 2, W_DOWN = W_UP + (size_t)5632 * 1024 * 2,
                 W_SSQY = W_DOWN + (size_t)1024 * 2816 * 2, W_SSQ2 = W_SSQY + (size_t)MT * 2 * 4, W_SSQ3 = W_SSQ2 + (size_t)MT * 4,
                 W_CTR = W_SSQ3 + (size_t)MT * 4, W_LBV = W_CTR + 256, W_DTB = W_LBV + 4096, W_T = W_DTB + (size_t)MT * 16 * 4,
                 W_FG = W_T + (size_t)65 * 2 * DFF * 4, W_FV = W_FG + (size_t)65 * 2 * DFF * 4, W_BIG = ((W_FV + (size_t)65 * 2 * DFF * 4 + 4095) / 4096) * 4096,
                 W_PROJ = W_BIG, W_X1 = W_BIG, W_X1B = W_X1 + (size_t)MT * 1024 * 4, W_HMID = W_X1B + (size_t)MT * 1024 * 2,
                 W_END = W_HMID + (size_t)MT * DFF * 2;
static_assert(W_PROJ + (size_t)MT * LDP * 2 <= W_END, "layout");

struct Params {
    const float *x_prompt, *x_sample, *st_hgrn, *st_ssm, *st_cs, *st_cf, *norm1_w, *w_in, *hgrn_lb, *hgrn_norm_w, *ssm_conv_w, *ssm_conv_b,
        *ssm_dt_bias, *ssm_a_log, *ssm_d, *ssm_norm_w, *w_out, *norm2_w, *w_up, *ffn_conv_w, *ffn_conv_b, *w_down, *final_norm_w;
    float* out; unsigned char* ws;
    int phase_lo, phase_hi;
};

DEV float bf2f(bf16_t v) { return __uint_as_float(((unsigned)v) << 16); }
typedef __bf16 bf16x2_t __attribute__((ext_vector_type(2)));
DEV unsigned cvt_pk_bf16(float lo, float hi) { f32x2 f = {lo, hi}; bf16x2_t v = __builtin_convertvector(f, bf16x2_t); return __builtin_bit_cast(unsigned, v); }
DEV bf16_t f2bf(float f) { return (bf16_t)(cvt_pk_bf16(f, 0.f) & 0xffffu); }
DEV float fexp2(float x) { return __builtin_amdgcn_exp2f(x); }
DEV float flog2(float x) { return __builtin_amdgcn_logf(x); }
DEV float frcp(float x) { return __builtin_amdgcn_rcpf(x); }
DEV float frsq(float x) { return __builtin_amdgcn_rsqf(x); }
DEV float sigmoidf_(float x) { return frcp(1.f + fexp2(-x * LOG2E)); }
DEV float siluf_(float x) { return x * sigmoidf_(x); }
DEV float softplusf_(float x) { return x > 20.f ? x : LN2 * flog2(1.f + fexp2(x * LOG2E)); }

namespace pg8 {
constexpr int BM = 256, BK = 64, HALF = 128, HTB = HALF * BK * 2, STAGE_BYTES = 8 * HTB, NXCD = 8, WGM = 8;
DEV int lds_byte(int r, int c) { const int st = (r >> 4) * 2 + (c >> 5), rr = r & 15, cc = c & 31, ob = rr * 64 + cc * 2; return st * 1024 + (ob ^ (((ob >> 9) & 1) << 5)); }
DEV void stage_rc(int b, int& R, int& C) { const int st = b / 1024, sb = b % 1024, swz = sb ^ (((sb >> 9) & 1) << 5); R = (st >> 1) * 16 + swz / 64; C = (st & 1) * 32 + (swz % 64) / 2; }
DEV int perm32(int rho) { const int n = rho >> 4, i = rho & 15; return 8 * (i >> 2) + 4 * n + (i & 3); }
struct Unit { int pm, pn; };
struct Gemm { const bf16_t* A; const bf16_t* Bt; int M, N, K; };
struct StaticOrder {
    int nM, nN, nwg, G, c;
    DEV void init(int M, int N, int G_, int c_) { nM = M / BM; nN = N / BM; nwg = nM * nN; G = G_; c = c_; }
    DEV bool next(int i, Unit& u) const {
        const long L = (long)i * G + c; if (L >= nwg) return false;
        int wgid = (int)L; { const int q = nwg / NXCD, r = nwg % NXCD, xcd = wgid % NXCD, off = wgid / NXCD; wgid = (xcd < r ? xcd * (q + 1) : r * (q + 1) + (xcd - r) * q) + off; }
        const int nig = WGM * nN, gid = wgid / nig, fm = gid * WGM, gsz = (nM - fm) < WGM ? (nM - fm) : WGM;
        u.pm = fm + ((wgid % nig) % gsz); u.pn = (wgid % nig) / gsz; return true;
    }
};

template <class Epi>
DEV void gemm_phase(LAS unsigned char* lds, const Gemm g, const StaticOrder& S, const Epi& E) {
    const int tid = threadIdx.x, wid = __builtin_amdgcn_readfirstlane(tid >> 6), lane = tid & 63, wr = wid >> 2, wc = wid & 3, fr = lane & 15, fq = lane >> 4;
    const int K = g.K, nt = K / BK;
    unsigned voffA[2], voffB[2];
#pragma unroll
    for (int i = 0; i < 2; ++i) { int R, C; stage_rc(tid * 16 + i * 8192, R, C); const int Rb = Epi::PERM ? ((R & ~31) + perm32(R & 31)) : R;
        voffA[i] = (unsigned)(R * K + C) * 2u; voffB[i] = (unsigned)(Rb * K + C) * 2u; }
    const size_t kstep = (size_t)(BK * 2);
    const size_t hstep = (size_t)HALF * K * 2;
    const size_t tstep = 2 * hstep;
    const unsigned ldsw = (unsigned)wid * 1024u;
    const int aoff = lds_byte(wr * 64 + fr, fq * 8), boff = lds_byte(wc * 32 + fr, fq * 8);
#define PG8_SA(b, h) (((b) * 2 + (h)) * HTB)
#define PG8_SB(b, h) ((4 + (b) * 2 + (h)) * HTB)
#define PG8_STAGE(bufoff, gbase, voff) do { _Pragma("unroll") for (int _i = 0; _i < 2; ++_i) \
        __builtin_amdgcn_global_load_lds((const unsigned*)((const char*)(gbase) + (voff)[_i]), (LAS unsigned*)(lds + (bufoff) + ldsw + _i * 8192), 16, 0, 0); } while (0)
#define PG8_LDA(dst, b, h) do { _Pragma("unroll") for (int m = 0; m < 4; ++m) _Pragma("unroll") for (int k = 0; k < 2; ++k) dst[m][k] = *(const LAS bf16x8*)(lds + PG8_SA(b, h) + aoff + m * 2048 + k * 1024); } while (0)
#define PG8_LDB(dst, b, h) do { _Pragma("unroll") for (int n = 0; n < 2; ++n) _Pragma("unroll") for (int k = 0; k < 2; ++k) dst[n][k] = *(const LAS bf16x8*)(lds + PG8_SB(b, h) + boff + n * 2048 + k * 1024); } while (0)
#define PG8_MMA(ai, bj, At, Bt) do { __builtin_amdgcn_s_setprio(1); _Pragma("unroll") for (int m = 0; m < 4; ++m) _Pragma("unroll") for (int n = 0; n < 2; ++n) _Pragma("unroll") for (int k = 0; k < 2; ++k) \
        acc[ai][bj][m][n] = __builtin_amdgcn_mfma_f32_16x16x32_bf16(Bt[n][k], At[m][k], acc[ai][bj][m][n], 0, 0, 0); __builtin_amdgcn_s_setprio(0); } while (0)
#define PG8_WAIT_V(n) asm volatile("s_waitcnt vmcnt(" #n ")" ::: "memory")
#define PG8_WAIT_L(n) asm volatile("s_waitcnt lgkmcnt(" #n ")" ::: "memory")
#define PG8_BAR __builtin_amdgcn_s_barrier()
#define PG8_SCHED __builtin_amdgcn_sched_barrier(0)
    Unit cur, nxt; int ui = 0;
    if (!S.next(0, cur)) return;
    f32x4 acc[2][2][4][2];
#pragma unroll
    for (int a = 0; a < 2; ++a)
#pragma unroll
        for (int b = 0; b < 2; ++b)
#pragma unroll
            for (int m = 0; m < 4; ++m)
#pragma unroll
                for (int n = 0; n < 2; ++n) acc[a][b][m][n] = (f32x4){0.f, 0.f, 0.f, 0.f};
    bf16x8 At[4][2], B0[2][2], B1[2][2];
    const char* cA = (const char*)g.A + (size_t)cur.pm * tstep; const char* cB = (const char*)g.Bt + (size_t)cur.pn * tstep;
    PG8_STAGE(PG8_SB(0, 0), cB, voffB); PG8_STAGE(PG8_SA(0, 0), cA, voffA); PG8_STAGE(PG8_SB(0, 1), cB + hstep, voffB); PG8_STAGE(PG8_SA(0, 1), cA + hstep, voffA);
    if (wr == 1) PG8_BAR;
    PG8_WAIT_V(4); PG8_BAR;
    PG8_STAGE(PG8_SB(1, 0), cB + kstep, voffB); PG8_STAGE(PG8_SA(1, 0), cA + kstep, voffA); PG8_STAGE(PG8_SB(1, 1), cB + hstep + kstep, voffB);
    PG8_WAIT_V(6); PG8_BAR;
    for (;;) {
        const bool has_next = S.next(ui + 1, nxt);
        const char* nA = has_next ? (const char*)g.A + (size_t)nxt.pm * tstep : cA; const char* nB = has_next ? (const char*)g.Bt + (size_t)nxt.pn * tstep : cB;
        for (int t = 0; t < nt; t += 2) {
            const bool last = (t == nt - 2);
            const char* a1 = cA + (size_t)(t + 1) * kstep;
            const char* a2 = last ? nA : cA + (size_t)(t + 2) * kstep; const char* b2 = last ? nB : cB + (size_t)(t + 2) * kstep;
            const char* a3 = a2 + kstep; const char* b3 = b2 + kstep;
            PG8_LDB(B0, 0, 0); PG8_SCHED; PG8_LDA(At, 0, 0); PG8_STAGE(PG8_SA(1, 1), a1 + hstep, voffA);
            PG8_WAIT_L(8); PG8_BAR; PG8_WAIT_L(0); PG8_MMA(0, 0, At, B0); PG8_BAR; PG8_SCHED;
            PG8_LDB(B1, 0, 1); PG8_STAGE(PG8_SB(0, 0), b2, voffB);
            PG8_BAR; PG8_WAIT_L(0); PG8_MMA(0, 1, At, B1); PG8_BAR;
            PG8_LDA(At, 0, 1); PG8_STAGE(PG8_SA(0, 0), a2, voffA);
            PG8_BAR; PG8_WAIT_L(0); PG8_MMA(1, 0, At, B0); PG8_BAR; PG8_SCHED;
            PG8_STAGE(PG8_SB(0, 1), b2 + hstep, voffB);
            PG8_WAIT_V(6); PG8_BAR; PG8_MMA(1, 1, At, B1); PG8_BAR;
            PG8_LDB(B0, 1, 0); PG8_SCHED; PG8_LDA(At, 1, 0); PG8_STAGE(PG8_SA(0, 1), a2 + hstep, voffA);
            PG8_WAIT_L(8); PG8_BAR; PG8_WAIT_L(0); PG8_MMA(0, 0, At, B0); PG8_BAR; PG8_SCHED;
            PG8_LDB(B1, 1, 1); PG8_STAGE(PG8_SB(1, 0), b3, voffB);
            PG8_BAR; PG8_WAIT_L(0); PG8_MMA(0, 1, At, B1); PG8_BAR;
            PG8_LDA(At, 1, 1); PG8_STAGE(PG8_SA(1, 0), a3, voffA);
            PG8_BAR; PG8_WAIT_L(0); PG8_MMA(1, 0, At, B0); PG8_BAR; PG8_SCHED;
            PG8_STAGE(PG8_SB(1, 1), b3 + hstep, voffB);
            PG8_WAIT_V(6); PG8_BAR; PG8_MMA(1, 1, At, B1); PG8_BAR;
        }
        E(acc, cur, wr, wc, fr, fq);
        if (!has_next) break;
#pragma unroll
        for (int a = 0; a < 2; ++a)
#pragma unroll
            for (int b = 0; b < 2; ++b)
#pragma unroll
                for (int m = 0; m < 4; ++m)
#pragma unroll
                    for (int n = 0; n < 2; ++n) acc[a][b][m][n] = (f32x4){0.f, 0.f, 0.f, 0.f};
        cur = nxt; cA = nA; cB = nB; ++ui;
    }
    PG8_WAIT_V(0);
    if (wr == 0) PG8_BAR;
    PG8_BAR;
#undef PG8_SA
#undef PG8_SB
#undef PG8_STAGE
#undef PG8_LDA
#undef PG8_LDB
#undef PG8_MMA
#undef PG8_WAIT_V
#undef PG8_WAIT_L
#undef PG8_BAR
#undef PG8_SCHED
}
}
using pg8::Unit;

struct EpiIn {
    static constexpr bool PERM = true;
    bf16_t* proj; bf16_t* mix; float* dtb; const float* lbv;
    DEV void operator()(const f32x4 (&acc)[2][2][4][2], const Unit& u, int wr, int wc, int fr, int fq) const {
        asm volatile("" : "+v"(fr), "+v"(fq));
#pragma unroll
        for (int bj = 0; bj < 2; ++bj) {
            const int cb = u.pn * 256 + bj * 128, c0 = cb + wc * 32 + fq * 8;
            int kind; bf16_t* dst; int ld;
            if (cb < 1024) { kind = 1; dst = proj + c0; ld = LDP; }
            else if (cb < 2048) { kind = 2; dst = proj + c0; ld = LDP; }
            else if (cb < 3072) { kind = 0; dst = proj + c0; ld = LDP; }
            else if (cb < 4096) { kind = 1; dst = mix + (c0 - 3072); ld = LDM; }
            else if (cb < 5120) { kind = 1; dst = mix + 1024 + (c0 - 4096); ld = LDM; }
            else if (cb < 6656) { kind = 0; dst = proj + 3072 + (c0 - 5120); ld = LDP; }
            else if (cb == 6656) { kind = 3; dst = nullptr; ld = 0; }
            else continue;
            f32x4 lb0 = {0.f, 0.f, 0.f, 0.f}, lb1 = {0.f, 0.f, 0.f, 0.f};
            if (kind == 2) { lb0 = *(const f32x4*)(lbv + c0 - 1024); lb1 = *(const f32x4*)(lbv + c0 - 1024 + 4); }
#pragma unroll
            for (int ai = 0; ai < 2; ++ai)
#pragma unroll
                for (int m = 0; m < 4; ++m) {
                    const int row = u.pm * 256 + ai * 128 + wr * 64 + m * 16 + fr;
                    if (row >= MV) continue;
                    f32x4 v0 = acc[ai][bj][m][0], v1 = acc[ai][bj][m][1];
                    if (kind == 3) { if (c0 < DIN) { float* d = dtb + (size_t)row * 16 + (c0 - 6656); *(f32x4*)d = v0; *(f32x4*)(d + 4) = v1; } continue; }
                    if (kind == 1) {
#pragma unroll
                        for (int j = 0; j < 4; ++j) { v0[j] = siluf_(v0[j]); v1[j] = siluf_(v1[j]); }
                    } else if (kind == 2) {
#pragma unroll
                        for (int j = 0; j < 4; ++j) { v0[j] = flog2(lb0[j] + (1.f - lb0[j]) * sigmoidf_(v0[j])); v1[j] = flog2(lb1[j] + (1.f - lb1[j]) * sigmoidf_(v1[j])); }
                    }
                    u32x4 w; w.x = cvt_pk_bf16(v0[0], v0[1]); w.y = cvt_pk_bf16(v0[2], v0[3]); w.z = cvt_pk_bf16(v1[0], v1[1]); w.w = cvt_pk_bf16(v1[2], v1[3]);
                    *(u32x4*)(dst + (size_t)row * ld) = w;
                }
        }
    }
};

struct EpiRes {
    static constexpr bool PERM = false;
    const float* r0; const float* r1;
    float* out; bf16_t* outb; float* ssq;
    DEV void operator()(const f32x4 (&acc)[2][2][4][2], const Unit& u, int wr, int wc, int fr, int fq) const {
        asm volatile("" : "+v"(fr), "+v"(fq));
#pragma unroll
        for (int ai = 0; ai < 2; ++ai)
#pragma unroll
            for (int m = 0; m < 4; ++m) {
                const int row = u.pm * 256 + ai * 128 + wr * 64 + m * 16 + fr;
                const bool ok = row < MV;
                float ss = 0.f;
                if (ok) {
                    const float* rr = row < NP ? r0 + (size_t)row * DM : r1 + (size_t)(row - NP) * DM;
#pragma unroll
                    for (int bj = 0; bj < 2; ++bj)
#pragma unroll
                        for (int n = 0; n < 2; ++n) {
                            const int c = u.pn * 256 + bj * 128 + wc * 32 + n * 16 + fq * 4;
                            f32x4 v = *(const f32x4*)(rr + c) + acc[ai][bj][m][n];
                            *(f32x4*)(out + (size_t)row * DM + c) = v;
                            if (outb) { u32x2 w; w.x = cvt_pk_bf16(v[0], v[1]); w.y = cvt_pk_bf16(v[2], v[3]); *(u32x2*)(outb + (size_t)row * DM + c) = w; }
                            ss += v[0] * v[0] + v[1] * v[1] + v[2] * v[2] + v[3] * v[3];
                        }
                }
                ss += __shfl_xor(ss, 16); ss += __shfl_xor(ss, 32);
                if (ok && fq == 0) atomicAdd(ssq + row, ss);
            }
    }
};

struct EpiUp {
    static constexpr bool PERM = true;
    bf16_t* hmid; const float* ssq2; const float* cw; const float* cbias; float* T; float* Fg; float* Fv; const float* st; float* cfp; float* cfs;
    LAS float* ex;
    DEV void operator()(const f32x4 (&acc)[2][2][4][2], const Unit& u, int wr, int wc, int fr, int fq) const {
        asm volatile("" : "+v"(fr), "+v"(fq));
        const int pm = u.pm, lane = fq * 16 + fr;
        const int chl = wc * 32 + fq * 8;
        const int ch0 = u.pn * 128 + chl;
#pragma unroll
        for (int ai = 0; ai < 2; ++ai) {
            const int row = pm * 256 + ai * 128 + wr * 64 + 48 + fr;
            const float rs = row < MV ? frsq(ssq2[row < MV ? row : 0] * (1.f / 1024.f) + EPS) : 0.f;
            if (fr >= 14) {
                LAS float* e = ex + ((ai * 2 + wr) * 2 + (fr - 14)) * 128 + chl;
                *(LAS f32x4*)e = acc[ai][0][3][0] * rs; *(LAS f32x4*)(e + 4) = acc[ai][0][3][1] * rs;
            }
        }
        __syncthreads(); __syncthreads();
        const int src1 = (lane & 48) | ((fr - 1) & 15), src2 = (lane & 48) | ((fr - 2) & 15);
        if (pm < 64) {
#pragma unroll
            for (int n = 0; n < 2; ++n) {
                const int ch = ch0 + n * 4;
                const f32x4 w0 = *(const f32x4*)(cw + ch), w1 = *(const f32x4*)(cw + DFF + ch), w2 = *(const f32x4*)(cw + 2 * DFF + ch), bb = *(const f32x4*)(cbias + ch);
#pragma unroll
                for (int ai = 0; ai < 2; ++ai) {
                    f32x4 p1 = {0.f, 0.f, 0.f, 0.f}, p2 = {0.f, 0.f, 0.f, 0.f};
                    const bool has_src = (wr == 1) || (ai == 1);
                    if (has_src) {
                        const int sb = (wr == 1) ? (ai * 2 + 0) : (0 * 2 + 1);
                        const LAS float* e = ex + sb * 256 + chl + n * 4;
                        p1 = *(const LAS f32x4*)(e + 128);
                        p2 = *(const LAS f32x4*)(e + (fr == 0 ? 0 : 128));
                    }
#pragma unroll
                    for (int m = 0; m < 4; ++m) {
                        const int row = pm * 256 + ai * 128 + wr * 64 + m * 16 + fr;
                        const float rs = frsq(ssq2[row] * (1.f / 1024.f) + EPS);
                        const f32x4 g = acc[ai][0][m][n] * rs, v = acc[ai][1][m][n] * rs;
                        f32x4 r1, r2;
#pragma unroll
                        for (int j = 0; j < 4; ++j) { r1[j] = __shfl(g[j], src1); r2[j] = __shfl(g[j], src2); }
                        const f32x4 q1 = fr >= 1 ? r1 : p1, q2 = fr >= 2 ? r2 : p2;
                        p1 = r1; p2 = r2;
                        f32x4 o;
#pragma unroll
                        for (int j = 0; j < 4; ++j) { const float cv = bb[j] + w0[j] * q2[j] + w1[j] * q1[j] + w2[j] * g[j]; o[j] = siluf_(cv) * v[j]; }
                        const bool defer = (ai == 0 && wr == 0 && m == 0 && fr < 2);
                        if (defer) {
                            *(f32x4*)(Fg + ((size_t)pm * 2 + fr) * DFF + ch) = g; *(f32x4*)(Fv + ((size_t)pm * 2 + fr) * DFF + ch) = v;
                        } else {
                            u32x2 w; w.x = cvt_pk_bf16(o[0], o[1]); w.y = cvt_pk_bf16(o[2], o[3]);
                            *(u32x2*)(hmid + (size_t)row * DFF + ch) = w;
                        }
                        if (ai == 1 && wr == 1 && m == 3 && fr >= 14) {
                            *(f32x4*)(T + ((size_t)pm * 2 + (fr - 14)) * DFF + ch) = g;
                            if ((pm & 7) == 7) *(f32x4*)(cfp + ((size_t)(pm >> 3) * 2 + (fr - 14)) * DFF + ch) = g;
                        }
                    }
                }
            }
        } else {
#pragma unroll
            for (int n = 0; n < 2; ++n) {
                const int ch = ch0 + n * 4;
                const f32x4 w0 = *(const f32x4*)(cw + ch), w1 = *(const f32x4*)(cw + DFF + ch), w2 = *(const f32x4*)(cw + 2 * DFF + ch), bb = *(const f32x4*)(cbias + ch);
#pragma unroll
                for (int m = 0; m < 4; ++m) {
                    const int b = wr * 64 + m * 16 + fr, row = NP + b;
                    const float rs = frsq(ssq2[row] * (1.f / 1024.f) + EPS);
                    const f32x4 g = acc[0][0][m][n] * rs, v = acc[0][1][m][n] * rs;
                    const f32x4 s0 = *(const f32x4*)(st + ((size_t)b * 2 + 0) * DFF + ch), s1 = *(const f32x4*)(st + ((size_t)b * 2 + 1) * DFF + ch);
                    f32x4 o;
#pragma unroll
                    for (int j = 0; j < 4; ++j) { const float cv = bb[j] + w0[j] * s0[j] + w1[j] * s1[j] + w2[j] * g[j]; o[j] = siluf_(cv) * v[j]; }
                    u32x2 w; w.x = cvt_pk_bf16(o[0], o[1]); w.y = cvt_pk_bf16(o[2], o[3]);
                    *(u32x2*)(hmid + (size_t)row * DFF + ch) = w;
                    *(f32x4*)(cfs + ((size_t)b * 2 + 0) * DFF + ch) = s1; *(f32x4*)(cfs + ((size_t)b * 2 + 1) * DFF + ch) = g;
                }
            }
        }
    }
};

DEV void mma16(f32x4& acc, const bf16_t* A, int lda, const bf16_t* Bt, int ldb, int K, int fr, int fq) {
    const bf16_t* a = A + fr * lda + fq * 8; const bf16_t* b = Bt + fr * ldb + fq * 8;
#pragma unroll
    for (int k = 0; k < K; k += 32) {
        const bf16x8 av = *(const bf16x8*)(a + k), bv = *(const bf16x8*)(b + k);
        acc = __builtin_amdgcn_mfma_f32_16x16x32_bf16(av, bv, acc, 0, 0, 0);
    }
}

DEV void transpose_weight(const float* __restrict__ src, bf16_t* __restrict__ dst, int K, int N, int Npad, int mode, const float* __restrict__ kscale, float* tile, int item) {
    const int ntn = Npad / 64, kt = item / ntn, ntile = item % ntn, k0 = kt * 64, n0 = ntile * 64, tid = threadIdx.x;
    int sc0 = n0;
    if (mode == 1) { const int pn = n0 >> 8, j = n0 & 255; sc0 = j < 128 ? pn * 128 + j : DFF + pn * 128 + (j - 128); }
    __syncthreads();
#pragma unroll
    for (int i = 0; i < 8; ++i) { const int e = tid + i * 512, kk = e >> 6, nn = e & 63; const int sc = sc0 + nn;
        tile[kk * 65 + nn] = (sc < N) ? src[(size_t)(k0 + kk) * N + sc] * (kscale ? kscale[k0 + kk] : 1.f) : 0.f; }
    __syncthreads();
#pragma unroll
    for (int i = 0; i < 4; ++i) { const int e = tid + i * 512, nn = e >> 5, kp = e & 31;
        *(unsigned*)(dst + (size_t)(n0 + nn) * K + k0 + kp * 2) = cvt_pk_bf16(tile[(kp * 2) * 65 + nn], tile[(kp * 2 + 1) * 65 + nn]); }
}

DEV void phase_prep(const Params& p, unsigned char* smem) {
    const int tid = threadIdx.x, gtid = blockIdx.x * 512 + tid, gsz = gridDim.x * 512;
    float* ssqy = (float*)(p.ws + W_SSQY);
    for (int i = gtid; i < (int)((W_LBV - W_SSQY) / 4); i += gsz) ssqy[i] = 0.f;
    float* lbv = (float*)(p.ws + W_LBV);
    for (int i = gtid; i < 1024; i += gsz) lbv[i] = sigmoidf_(p.hgrn_lb[i] - p.hgrn_lb[1024 + i]);
    bf16_t* wb_in = (bf16_t*)((unsigned char*)p.out + O_HS * 4 + (size_t)MT * 1024 * 2);
    float* tile = (float*)smem;
    const int n_in = 16 * (DINP / 64), n_out = 32 * 16, n_up = 16 * 88, n_down = 44 * 16;
    for (int it = blockIdx.x; it < n_in + n_out + n_up + n_down; it += gridDim.x) {
        if (it < n_in) transpose_weight(p.w_in, wb_in, 1024, DIN, DINP, 0, nullptr, tile, it);
        else if (it < n_in + n_out) transpose_weight(p.w_out, (bf16_t*)(p.ws + W_OUT), 2048, 1024, 1024, 0, nullptr, tile, it - n_in);
        else if (it < n_in + n_out + n_up) transpose_weight(p.w_up, (bf16_t*)(p.ws + W_UP), 1024, 5632, 5632, 1, p.norm2_w, tile, it - n_in - n_out);
        else transpose_weight(p.w_down, (bf16_t*)(p.ws + W_DOWN), 2816, 1024, 1024, 0, nullptr, tile, it - n_in - n_out - n_up);
    }
    bf16_t* h = (bf16_t*)((unsigned char*)p.out + O_HS * 4);
    const int wid = tid >> 6, lane = tid & 63;
    for (int row = blockIdx.x * 8 + wid; row < MT; row += gridDim.x * 8) {
        if (row >= MV) {
#pragma unroll
            for (int i = 0; i < 4; ++i) *(u32x2*)(h + (size_t)row * DM + i * 256 + lane * 4) = (u32x2){0u, 0u};
            continue;
        }
        const float* xr = row < NP ? p.x_prompt + (size_t)row * DM : p.x_sample + (size_t)(row - NP) * DM;
        f32x4 v[4]; float ss = 0.f;
#pragma unroll
        for (int i = 0; i < 4; ++i) { v[i] = *(const f32x4*)(xr + i * 256 + lane * 4); ss += v[i][0] * v[i][0] + v[i][1] * v[i][1] + v[i][2] * v[i][2] + v[i][3] * v[i][3]; }
#pragma unroll
        for (int o = 32; o >= 1; o >>= 1) ss += __shfl_xor(ss, o);
        const float rs = frsq(ss * (1.f / 1024.f) + EPS);
#pragma unroll
        for (int i = 0; i < 4; ++i) { const f32x4 w = *(const f32x4*)(p.norm1_w + i * 256 + lane * 4);
            u32x2 o; o.x = cvt_pk_bf16(v[i][0] * rs * w[0], v[i][1] * rs * w[1]); o.y = cvt_pk_bf16(v[i][2] * rs * w[2], v[i][3] * rs * w[3]);
            *(u32x2*)(h + (size_t)row * DM + i * 256 + lane * 4) = o; }
    }
}

DEV void hgrn_prompt_item(const Params& p, int b, int hh, unsigned char* smem) {
    constexpr int LQ = 136, LS = 72;
    bf16_t* Q = (bf16_t*)smem;
    bf16_t* KT = Q + 64 * LQ;
    bf16_t* KH = KT + 64 * LQ;
    bf16_t* VT = KH + 128 * LS;
    bf16_t* PM = VT + 128 * LS;
    bf16_t* ST = PM + 64 * LS;
    float* DV = (float*)(ST + 128 * LQ);
    float* TOT = DV + 128;
    float* RS = TOT + 8 * 128;
    const int tid = threadIdx.x, wid = __builtin_amdgcn_readfirstlane(tid >> 6), lane0 = tid & 63;
    const bf16_t* proj = (const bf16_t*)(p.ws + W_PROJ);
    bf16_t* mix = (bf16_t*)p.out;
    __syncthreads();
    for (int i = tid; i < 128 * LQ / 2; i += 512) ((unsigned*)ST)[i] = 0u;
    f32x4 S[8];
#pragma unroll
    for (int i = 0; i < 8; ++i) S[i] = (f32x4){0.f, 0.f, 0.f, 0.f};
    int lane = lane0, fr = lane & 15, fq = lane >> 4;
    for (int c = 0; c < 32; ++c) {
        lane = lane0; asm volatile("" : "+v"(lane));
        fr = lane & 15; fq = lane >> 4;
        const int kp = lane * 2;
        const size_t r0 = (size_t)b * SEQ + c * 64;
        float g0[8], g1[8], q0[8], q1[8];
#pragma unroll
        for (int i = 0; i < 8; ++i) {
            const bf16_t* pr = proj + (r0 + wid * 8 + i) * LDP + hh * 128 + kp;
            const unsigned gq = *(const unsigned*)(pr + 1024), qq = *(const unsigned*)pr;
            g0[i] = __uint_as_float(gq << 16); g1[i] = __uint_as_float(gq & 0xffff0000u);
            q0[i] = __uint_as_float(qq << 16); q1[i] = __uint_as_float(qq & 0xffff0000u);
        }
        float kk0[8], kk1[8];
#pragma unroll
        for (int i = 0; i < 8; ++i) { kk0[i] = 1.f - fexp2(g0[i]); kk1[i] = 1.f - fexp2(g1[i]); }
#pragma unroll
        for (int i = 1; i < 8; ++i) { g0[i] += g0[i - 1]; g1[i] += g1[i - 1]; }
        *(f32x2*)(TOT + wid * 128 + kp) = (f32x2){g0[7], g1[7]};
        {
            const int s = lane, v0 = wid * 16;
            const bf16_t* pv = proj + (r0 + s) * LDP + 2048 + hh * 128 + v0;
            const bf16x8 a = *(const bf16x8*)pv, b2 = *(const bf16x8*)(pv + 8);
#pragma unroll
            for (int j = 0; j < 8; ++j) { VT[(v0 + j) * LS + s] = (bf16_t)a[j]; VT[(v0 + 8 + j) * LS + s] = (bf16_t)b2[j]; }
        }
        __syncthreads();
        {
            float pre0 = 0.f, pre1 = 0.f, tot0 = 0.f, tot1 = 0.f;
#pragma unroll
            for (int w = 0; w < 8; ++w) { const f32x2 t = *(const f32x2*)(TOT + w * 128 + kp); if (w < wid) { pre0 += t.x; pre1 += t.y; } tot0 += t.x; tot1 += t.y; }
            if (wid == 0) *(f32x2*)(DV + kp) = (f32x2){fexp2(tot0), fexp2(tot1)};
#pragma unroll
            for (int i = 0; i < 8; ++i) {
                const int t = wid * 8 + i;
                const float b0 = g0[i] + pre0, b1 = g1[i] + pre1;
                const float e0 = fexp2(b0), e1 = fexp2(b1), n0 = fexp2(-b0), n1 = fexp2(-b1), l0 = fexp2(tot0 - b0), l1 = fexp2(tot1 - b1);
                *(unsigned*)(Q + t * LQ + kp) = cvt_pk_bf16(q0[i] * e0, q1[i] * e1);
                *(unsigned*)(KT + t * LQ + kp) = cvt_pk_bf16(kk0[i] * n0, kk1[i] * n1);
                KH[kp * LS + t] = f2bf(kk0[i] * l0); KH[(kp + 1) * LS + t] = f2bf(kk1[i] * l1);
            }
        }
        __syncthreads();
        {
            const int ti = wid >> 1;
#pragma unroll
            for (int x = 0; x < 2; ++x) {
                const int si = (wid & 1) * 2 + x;
                f32x4 a = {0.f, 0.f, 0.f, 0.f};
                if (si <= ti) mma16(a, Q + ti * 16 * LQ, LQ, KT + si * 16 * LQ, LQ, 128, fr, fq);
#pragma unroll
                for (int j = 0; j < 4; ++j) { const int t = ti * 16 + fq * 4 + j, s = si * 16 + fr; PM[t * LS + s] = f2bf(s <= t ? a[j] : 0.f); }
            }
        }
        f32x4 o[4];
        const int oti = wid & 3, ovb = (wid >> 2) * 4;
#pragma unroll
        for (int x = 0; x < 4; ++x) { o[x] = (f32x4){0.f, 0.f, 0.f, 0.f}; mma16(o[x], Q + oti * 16 * LQ, LQ, ST + (ovb + x) * 16 * LQ, LQ, 128, fr, fq); }
        __syncthreads();
        float rsum[4] = {0.f, 0.f, 0.f, 0.f};
#pragma unroll
        for (int x = 0; x < 4; ++x) { mma16(o[x], PM + oti * 16 * LS, LS, VT + (ovb + x) * 16 * LS, LS, 64, fr, fq);
#pragma unroll
            for (int j = 0; j < 4; ++j) rsum[j] += o[x][j] * o[x][j]; }
#pragma unroll
        for (int j = 0; j < 4; ++j) { float r = rsum[j]; r += __shfl_xor(r, 1); r += __shfl_xor(r, 2); r += __shfl_xor(r, 4); r += __shfl_xor(r, 8); if (fr == 0) RS[(wid >> 2) * 64 + oti * 16 + fq * 4 + j] = r; }
        {
            const f32x4 dv = *(const f32x4*)(DV + wid * 16 + fq * 4);
#pragma unroll
            for (int x = 0; x < 8; ++x) {
                S[x] = S[x] * dv;
                mma16(S[x], KH + wid * 16 * LS, LS, VT + x * 16 * LS, LS, 64, fr, fq);
                u32x2 w; w.x = cvt_pk_bf16(S[x][0], S[x][1]); w.y = cvt_pk_bf16(S[x][2], S[x][3]);
                *(u32x2*)(ST + (x * 16 + fr) * LQ + wid * 16 + fq * 4) = w;
            }
        }
        __syncthreads();
#pragma unroll
        for (int j = 0; j < 4; ++j) {
            const int t = oti * 16 + fq * 4 + j;
            const float rstd = frsq((RS[t] + RS[64 + t]) * (1.f / 128.f) + EPS);
#pragma unroll
            for (int x = 0; x < 4; ++x) {
                const int v = (ovb + x) * 16 + fr;
                bf16_t* mp = mix + (r0 + t) * LDM + hh * 128 + v;
#if PROBE_NOMIX == 2
                *mp = f2bf(o[x][j] * rstd * p.hgrn_norm_w[v]);
#elif PROBE_NOMIX == 3
                *mp = f2bf(o[x][j]);
#elif PROBE_NOMIX == 0
                *mp = f2bf(o[x][j] * rstd * p.hgrn_norm_w[v] * bf2f(*mp));
#endif
            }
        }
    }
    float* hp = p.out + O_HP + ((size_t)(b * 8 + hh)) * 128 * 128;
#pragma unroll
    for (int x = 0; x < 8; ++x)
#pragma unroll
        for (int j = 0; j < 4; ++j) hp[(size_t)(wid * 16 + fq * 4 + j) * 128 + x * 16 + fr] = S[x][j];
}

DEV void ssd_prompt_item(const Params& p, int b, int hh, unsigned char* smem) {
    constexpr int LN_ = 136, LS = 72;
    bf16_t* XD = (bf16_t*)smem;
    bf16_t* XE = XD + 64 * LS;
    bf16_t* XT = XE + 64 * LS;
    bf16_t* BN = XT + 64 * LS;
    bf16_t* BT = BN + 64 * LN_;
    bf16_t* CN = BT + 128 * LS;
    bf16_t* MM = CN + 64 * LN_;
    bf16_t* SB = MM + 64 * LS;
    float* ACS = (float*)(SB + 64 * LN_);
    const int tid = threadIdx.x, wid = __builtin_amdgcn_readfirstlane(tid >> 6), lane0 = tid & 63;
    int lane = lane0, fr = lane & 15, fq = lane >> 4;
    const int grp = hh >> 3;
    const bf16_t* proj = (const bf16_t*)(p.ws + W_PROJ);
    const float* dtb = (const float*)(p.ws + W_DTB);
    float* ssqy = (float*)(p.ws + W_SSQY);
    bf16_t* mix = (bf16_t*)p.out;
    __syncthreads();
    for (int i = tid; i < 64 * LN_ / 2; i += 512) ((unsigned*)SB)[i] = 0u;
    f32x4 S[4];
#pragma unroll
    for (int i = 0; i < 4; ++i) S[i] = (f32x4){0.f, 0.f, 0.f, 0.f};
    const float Ah = -__expf(p.ssm_a_log[hh]) * LOG2E, dtbias = p.ssm_dt_bias[hh], Dh = p.ssm_d[hh];
    const int cx = hh * 64 + wid * 8, cB = 1024 + grp * 128 + wid * 16, cC = 1280 + grp * 128 + wid * 16;
    for (int c = 0; c < 32; ++c) {
        lane = lane0; asm volatile("" : "+v"(lane));
        fr = lane & 15; fq = lane >> 4;
        const size_t r0 = (size_t)b * SEQ + c * 64;
        const int t = lane;
        const float dt = softplusf_(dtb[(r0 + t) * 16 + hh] + dtbias);
        float acs = Ah * dt;
#pragma unroll
        for (int o = 1; o < 64; o <<= 1) { const float u = __shfl_up(acs, o); if (lane >= o) acs += u; }
        const float alast = __shfl(acs, 63);
        if (wid == 0) ACS[t] = acs;
        const float decl = fexp2(alast - acs);
        const int tpos = c * 64 + t;
#pragma unroll 1
        for (int part = 0; part < 5; ++part) {
            const int cbase = part == 0 ? cx : (part < 3 ? cB + (part - 1) * 8 : cC + (part - 3) * 8);
            float a[8];
#pragma unroll
            for (int j = 0; j < 8; ++j) a[j] = p.ssm_conv_b[cbase + j];
#pragma unroll
            for (int tap = 0; tap < 4; ++tap) {
                if (tpos - 3 + tap >= 0) {
                    const bf16x8 rv = *(const bf16x8*)(proj + (r0 + t - 3 + tap) * LDP + 3072 + cbase);
#pragma unroll
                    for (int j = 0; j < 8; ++j) a[j] += p.ssm_conv_w[tap * 1536 + cbase + j] * bf2f((bf16_t)rv[j]);
                }
            }
#pragma unroll
            for (int j = 0; j < 8; ++j) a[j] = siluf_(a[j]);
            if (part == 0) {
#pragma unroll
                for (int j = 0; j < 8; ++j) { const int pp = wid * 8 + j; XT[pp * LS + t] = f2bf(a[j]); XD[pp * LS + t] = f2bf(a[j] * dt); XE[pp * LS + t] = f2bf(a[j] * dt * decl); }
            } else if (part < 3) {
                const int n0 = wid * 16 + (part - 1) * 8;
                u32x4 w; w.x = cvt_pk_bf16(a[0], a[1]); w.y = cvt_pk_bf16(a[2], a[3]); w.z = cvt_pk_bf16(a[4], a[5]); w.w = cvt_pk_bf16(a[6], a[7]);
                *(u32x4*)(BN + t * LN_ + n0) = w;
#pragma unroll
                for (int j = 0; j < 8; ++j) BT[(n0 + j) * LS + t] = f2bf(a[j]);
            } else {
                const int n0 = wid * 16 + (part - 3) * 8;
                u32x4 w; w.x = cvt_pk_bf16(a[0], a[1]); w.y = cvt_pk_bf16(a[2], a[3]); w.z = cvt_pk_bf16(a[4], a[5]); w.w = cvt_pk_bf16(a[6], a[7]);
                *(u32x4*)(CN + t * LN_ + n0) = w;
            }
        }
        __syncthreads();
        {
            const int ti = wid >> 1;
#pragma unroll
            for (int x = 0; x < 2; ++x) {
                const int si = (wid & 1) * 2 + x;
                f32x4 a = {0.f, 0.f, 0.f, 0.f};
                if (si <= ti) mma16(a, CN + ti * 16 * LN_, LN_, BN + si * 16 * LN_, LN_, 128, fr, fq);
                const float as = ACS[si * 16 + fr];
#pragma unroll
                for (int j = 0; j < 4; ++j) { const int tt = ti * 16 + fq * 4 + j, s = si * 16 + fr; MM[tt * LS + s] = f2bf(s <= tt ? a[j] * fexp2(ACS[tt] - as) : 0.f); }
            }
        }
        f32x4 y[2];
        const int yti = wid & 3, ypb = (wid >> 2) * 2;
#pragma unroll
        for (int x = 0; x < 2; ++x) { y[x] = (f32x4){0.f, 0.f, 0.f, 0.f}; mma16(y[x], CN + yti * 16 * LN_, LN_, SB + (ypb + x) * 16 * LN_, LN_, 128, fr, fq);
#pragma unroll
            for (int j = 0; j < 4; ++j) y[x][j] *= fexp2(ACS[yti * 16 + fq * 4 + j]); }
        __syncthreads();
        float rsum[4] = {0.f, 0.f, 0.f, 0.f};
#pragma unroll
        for (int x = 0; x < 2; ++x) {
            mma16(y[x], MM + yti * 16 * LS, LS, XD + (ypb + x) * 16 * LS, LS, 64, fr, fq);
            const int pp = (ypb + x) * 16 + fr;
            const float wn = p.ssm_norm_w[hh * 64 + pp];
#pragma unroll
            for (int j = 0; j < 4; ++j) {
                const int tt = yti * 16 + fq * 4 + j;
                bf16_t* mp = mix + (r0 + tt) * LDM + 1024 + hh * 64 + pp;
                const float yv = (y[x][j] + Dh * bf2f(XT[pp * LS + tt])) * bf2f(*mp);
                rsum[j] += yv * yv;
                *mp = f2bf(yv * wn);
            }
        }
#pragma unroll
        for (int j = 0; j < 4; ++j) { float r = rsum[j]; r += __shfl_xor(r, 1); r += __shfl_xor(r, 2); r += __shfl_xor(r, 4); r += __shfl_xor(r, 8);
            if (fr == 0) atomicAdd(ssqy + (r0 + yti * 16 + fq * 4 + j) * 2 + grp, r); }
        {
            const float dl = fexp2(alast);
            const int pt = wid & 3, nb = (wid >> 2) * 4;
#pragma unroll
            for (int x = 0; x < 4; ++x) {
                S[x] = S[x] * dl;
                mma16(S[x], XE + pt * 16 * LS, LS, BT + (nb + x) * 16 * LS, LS, 64, fr, fq);
#pragma unroll
                for (int j = 0; j < 4; ++j) SB[(pt * 16 + fq * 4 + j) * LN_ + (nb + x) * 16 + fr] = f2bf(S[x][j]);
            }
        }
        __syncthreads();
    }
    {
        float* sp = p.out + O_SP + ((size_t)(b * 16 + hh)) * 64 * 128;
        const int pt = wid & 3, nb = (wid >> 2) * 4;
#pragma unroll
        for (int x = 0; x < 4; ++x)
#pragma unroll
            for (int j = 0; j < 4; ++j) sp[(size_t)(pt * 16 + fq * 4 + j) * 128 + (nb + x) * 16 + fr] = S[x][j];
    }
    if (tid < 288) { const int j = tid / 96, cc = hh * 96 + tid % 96;
        p.out[O_CSP + ((size_t)b * 3 + j) * 1536 + cc] = bf2f(proj[((size_t)b * SEQ + 2045 + j) * LDP + 3072 + cc]); }
}

DEV void hgrn_sample_item(const Params& p, int b, int hh, unsigned char* smem) {
    float* qv = (float*)smem; float* fv = qv + 128; float* kv = fv + 128; float* vv = kv + 128; float* red = vv + 128; float* sc = red + 16 * 128;
    const int tid = threadIdx.x;
    const size_t row = NP + b;
    const bf16_t* pr = (const bf16_t*)(p.ws + W_PROJ) + row * LDP + hh * 128;
    bf16_t* mix = (bf16_t*)p.out + row * LDM + hh * 128;
    __syncthreads();
    if (tid < 128) { const float f = fexp2(bf2f(pr[1024 + tid])); qv[tid] = bf2f(pr[tid]); fv[tid] = f; kv[tid] = 1.f - f; vv[tid] = bf2f(pr[2048 + tid]); }
    __syncthreads();
    const int v4 = tid & 31, kq = tid >> 5;
    const float* Sin = p.st_hgrn + ((size_t)(b * 8 + hh)) * 16384; float* Sout = p.out + O_HS + ((size_t)(b * 8 + hh)) * 16384;
    const f32x4 vx = *(const f32x4*)(vv + v4 * 4);
    f32x4 acc = {0.f, 0.f, 0.f, 0.f};
#pragma unroll
    for (int i = 0; i < 8; ++i) { const int k = kq * 8 + i; const f32x4 s = *(const f32x4*)(Sin + k * 128 + v4 * 4); const f32x4 sn = s * fv[k] + vx * kv[k];
        *(f32x4*)(Sout + k * 128 + v4 * 4) = sn; acc += sn * qv[k]; }
    *(f32x4*)(red + kq * 128 + v4 * 4) = acc;
    __syncthreads();
    float o = 0.f;
    if (tid < 128) {
#pragma unroll
        for (int i = 0; i < 16; ++i) o += red[i * 128 + tid];
        float ss = o * o;
#pragma unroll
        for (int x = 32; x >= 1; x >>= 1) ss += __shfl_xor(ss, x);
        if ((tid & 63) == 0) sc[tid >> 6] = ss;
    }
    __syncthreads();
    if (tid < 128) { const float rstd = frsq((sc[0] + sc[1]) * (1.f / 128.f) + EPS); mix[tid] = f2bf(o * rstd * p.hgrn_norm_w[tid] * bf2f(mix[tid])); }
}

DEV void ssd_sample_item(const Params& p, int b, int hh, unsigned char* smem) {
    float* xs = (float*)smem; float* Bv = xs + 64; float* Cv = Bv + 128; float* yv = Cv + 128;
    const int tid = threadIdx.x, grp = hh >> 3;
    const size_t row = NP + b;
    const bf16_t* pr = (const bf16_t*)(p.ws + W_PROJ) + row * LDP + 3072;
    const float* st = p.st_cs + (size_t)b * 3 * 1536;
    bf16_t* mix = (bf16_t*)p.out + row * LDM + 1024 + hh * 64;
    __syncthreads();
    if (tid < 320) {
        const int cc = tid < 64 ? hh * 64 + tid : (tid < 192 ? 1024 + grp * 128 + (tid - 64) : 1280 + grp * 128 + (tid - 192));
        float a = p.ssm_conv_b[cc] + p.ssm_conv_w[cc] * st[cc] + p.ssm_conv_w[1536 + cc] * st[1536 + cc] + p.ssm_conv_w[3072 + cc] * st[3072 + cc] + p.ssm_conv_w[4608 + cc] * bf2f(pr[cc]);
        a = siluf_(a);
        if (tid < 64) xs[tid] = a; else if (tid < 192) Bv[tid - 64] = a; else Cv[tid - 192] = a;
    }
    if (tid >= 384 && tid < 480) { const int cc = hh * 96 + (tid - 384);
        float* o = p.out + O_CSS + (size_t)b * 3 * 1536; o[cc] = st[1536 + cc]; o[1536 + cc] = st[3072 + cc]; o[3072 + cc] = bf2f(pr[cc]); }
    __syncthreads();
    const float dt = softplusf_(((const float*)(p.ws + W_DTB))[row * 16 + hh] + p.ssm_dt_bias[hh]);
    const float dA = __expf(-__expf(p.ssm_a_log[hh]) * dt), Dh = p.ssm_d[hh];
    const int n4 = tid & 31, pq = tid >> 5;
    const float* Sin = p.st_ssm + ((size_t)(b * 16 + hh)) * 8192; float* Sout = p.out + O_SS + ((size_t)(b * 16 + hh)) * 8192;
    const f32x4 Bx = *(const f32x4*)(Bv + n4 * 4), Cx = *(const f32x4*)(Cv + n4 * 4);
#pragma unroll
    for (int i = 0; i < 4; ++i) {
        const int pp = pq * 4 + i; const float xd = xs[pp] * dt;
        const f32x4 s = *(const f32x4*)(Sin + pp * 128 + n4 * 4); const f32x4 sn = s * dA + Bx * xd;
        *(f32x4*)(Sout + pp * 128 + n4 * 4) = sn;
        float part = sn[0] * Cx[0] + sn[1] * Cx[1] + sn[2] * Cx[2] + sn[3] * Cx[3];
#pragma unroll
        for (int x = 16; x >= 1; x >>= 1) part += __shfl_xor(part, x);
        if (n4 == 0) yv[pp] = part + Dh * xs[pp];
    }
    __syncthreads();
    if (tid < 64) {
        const float y = yv[tid] * bf2f(mix[tid]);
        float ss = y * y;
#pragma unroll
        for (int x = 32; x >= 1; x >>= 1) ss += __shfl_xor(ss, x);
        if (tid == 0) atomicAdd((float*)(p.ws + W_SSQY) + row * 2 + grp, ss);
        mix[tid] = f2bf(y * p.ssm_norm_w[hh * 64 + tid]);
    }
}

DEV void phase_scan(const Params& p, unsigned char* smem) {
#ifndef PROBE_SCAN
#define PROBE_SCAN 7
#endif
    for (int it = blockIdx.x; it < 192; it += gridDim.x) {
        if (it < 64) { if (PROBE_SCAN & 1) hgrn_prompt_item(p, it >> 3, it & 7, smem); }
        else if (PROBE_SCAN & 2) ssd_prompt_item(p, (it - 64) >> 4, (it - 64) & 15, smem);
    }
    if (!(PROBE_SCAN & 4)) return;
    unsigned* ctr = (unsigned*)(p.ws + W_CTR);
    LAS unsigned* slot = (LAS unsigned*)(smem + LDS_BYTES - 16);
    for (;;) {
        __syncthreads();
        if (threadIdx.x == 0) *slot = atomicAdd(ctr, 1u);
        __syncthreads();
        const unsigned j = *slot;
        if (j >= 3072u) break;
        if (j < 1024u) hgrn_sample_item(p, j >> 3, j & 7, smem);
        else ssd_sample_item(p, (j - 1024u) >> 4, (j - 1024u) & 15, smem);
    }
}

DEV void phase_yscale(const Params& p) {
    bf16_t* mix = (bf16_t*)p.out; const float* ssqy = (const float*)(p.ws + W_SSQY);
    for (int i = blockIdx.x * 512 + threadIdx.x; i < MV * 128; i += gridDim.x * 512) {
        const int row = i >> 7, c8 = i & 127;
        const float rs = frsq(ssqy[row * 2 + (c8 >> 6)] * (1.f / 512.f) + EPS);
        u32x4* ptr = (u32x4*)(mix + (size_t)row * LDM + 1024 + c8 * 8);
        u32x4 w = *ptr;
        unsigned* ww = (unsigned*)&w;
#pragma unroll
        for (int j = 0; j < 4; ++j) ww[j] = cvt_pk_bf16(__uint_as_float(ww[j] << 16) * rs, __uint_as_float(ww[j] & 0xffff0000u) * rs);
        *ptr = w;
    }
}

DEV void fix_hmid_rows(const Params& p, int pm) {
    const float* T = (const float*)(p.ws + W_T); const float* Fg = (const float*)(p.ws + W_FG); const float* Fv = (const float*)(p.ws + W_FV);
    bf16_t* hmid = (bf16_t*)(p.ws + W_HMID);
    for (int ch = threadIdx.x; ch < DFF; ch += 512) {
        const bool first = (pm & 7) == 0;
        const float gm2 = first ? 0.f : T[((size_t)(pm - 1) * 2 + 0) * DFF + ch], gm1 = first ? 0.f : T[((size_t)(pm - 1) * 2 + 1) * DFF + ch];
        const float G0 = Fg[((size_t)pm * 2 + 0) * DFF + ch], G1 = Fg[((size_t)pm * 2 + 1) * DFF + ch];
        const float v0 = Fv[((size_t)pm * 2 + 0) * DFF + ch], v1 = Fv[((size_t)pm * 2 + 1) * DFF + ch];
        const float w0 = p.ffn_conv_w[ch], w1 = p.ffn_conv_w[DFF + ch], w2 = p.ffn_conv_w[2 * DFF + ch], bb = p.ffn_conv_b[ch];
        hmid[(size_t)(pm * 256) * DFF + ch] = f2bf(siluf_(bb + w0 * gm2 + w1 * gm1 + w2 * G0) * v0);
        hmid[(size_t)(pm * 256 + 1) * DFF + ch] = f2bf(siluf_(bb + w0 * gm1 + w1 * G0 + w2 * G1) * v1);
    }
}

DEV void phase_final(const Params& p) {
    const float* ssq3 = (const float*)(p.ws + W_SSQ3);
    const int wid = threadIdx.x >> 6, lane = threadIdx.x & 63;
    for (int row = blockIdx.x * 8 + wid; row < MV; row += gridDim.x * 8) {
        const float rs = frsq(ssq3[row] * (1.f / 1024.f) + EPS);
        float* yr = p.out + (size_t)row * DM;
#pragma unroll
        for (int i = 0; i < 4; ++i) { const int c = i * 256 + lane * 4; const f32x4 w = *(const f32x4*)(p.final_norm_w + c); f32x4 v = *(const f32x4*)(yr + c);
            v = v * w * rs; *(f32x4*)(yr + c) = v; }
    }
}

__global__ void __launch_bounds__(512, 2) hymba_fwd(Params p) {
    extern __shared__ __attribute__((aligned(16))) unsigned char smem[];
    cg::grid_group grid = cg::this_grid();
    LAS unsigned char* lds = (LAS unsigned char*)smem;
    bf16_t* h = (bf16_t*)((unsigned char*)p.out + O_HS * 4);
    bf16_t* wb_in = h + (size_t)MT * 1024;
    bf16_t* mix = (bf16_t*)p.out;
#define PHASE_BEGIN(k) if (p.phase_lo <= (k) && (k) < p.phase_hi) { if ((k) != p.phase_lo) grid.sync();
#define PHASE_END }
    PHASE_BEGIN(0) phase_prep(p, smem); PHASE_END
    PHASE_BEGIN(1)
        pg8::StaticOrder S; S.init(MT, DINP, gridDim.x, blockIdx.x);
        EpiIn E{(bf16_t*)(p.ws + W_PROJ), mix, (float*)(p.ws + W_DTB), (const float*)(p.ws + W_LBV)};
        pg8::gemm_phase(lds, pg8::Gemm{h, wb_in, MT, DINP, 1024}, S, E);
    PHASE_END
    PHASE_BEGIN(2) phase_scan(p, smem); PHASE_END
    PHASE_BEGIN(3) phase_yscale(p); PHASE_END
    PHASE_BEGIN(4)
        pg8::StaticOrder S; S.init(MT, 1024, gridDim.x, blockIdx.x);
        EpiRes E{p.x_prompt, p.x_sample, (float*)(p.ws + W_X1), (bf16_t*)(p.ws + W_X1B), (float*)(p.ws + W_SSQ2)};
        pg8::gemm_phase(lds, pg8::Gemm{mix, (const bf16_t*)(p.ws + W_OUT), MT, 1024, 2048}, S, E);
    PHASE_END
    PHASE_BEGIN(5)
        pg8::StaticOrder S; S.init(MT, 5632, gridDim.x, blockIdx.x);
        EpiUp E{(bf16_t*)(p.ws + W_HMID), (const float*)(p.ws + W_SSQ2), p.ffn_conv_w, p.ffn_conv_b, (float*)(p.ws + W_T), (float*)(p.ws + W_FG), (float*)(p.ws + W_FV),
                p.st_cf, p.out + O_CFP, p.out + O_CFS, (LAS float*)(lds + 131072)};
        pg8::gemm_phase(lds, pg8::Gemm{(const bf16_t*)(p.ws + W_X1B), (const bf16_t*)(p.ws + W_UP), MT, 5632, 1024}, S, E);
    PHASE_END
    PHASE_BEGIN(6) for (int pm = blockIdx.x; pm < 64; pm += gridDim.x) fix_hmid_rows(p, pm); PHASE_END
    PHASE_BEGIN(7)
        pg8::StaticOrder S; S.init(MT, 1024, gridDim.x, blockIdx.x);
        const float* x1 = (const float*)(p.ws + W_X1);
        EpiRes E{x1, x1 + (size_t)NP * DM, p.out, nullptr, (float*)(p.ws + W_SSQ3)};
        pg8::gemm_phase(lds, pg8::Gemm{(const bf16_t*)(p.ws + W_HMID), (const bf16_t*)(p.ws + W_DOWN), MT, 1024, DFF}, S, E);
    PHASE_END
    PHASE_BEGIN(8) phase_final(p); PHASE_END
}

extern "C" void kernel_launch(void* const* d_in, const int* in_sizes, int n_in, void* d_out, int out_size, void* d_ws, size_t ws_size, hipStream_t stream) {
    static int grid_blocks = 0;
    if (!grid_blocks) {
        int dev = 0, cus = 0, per_cu = 0;
        hipGetDevice(&dev);
        hipDeviceGetAttribute(&cus, hipDeviceAttributeMultiprocessorCount, dev);
        hipFuncSetAttribute((const void*)hymba_fwd, hipFuncAttributeMaxDynamicSharedMemorySize, LDS_BYTES);
        hipOccupancyMaxActiveBlocksPerMultiprocessor(&per_cu, hymba_fwd, 512, LDS_BYTES);
        if (per_cu < 1) per_cu = 1;
        grid_blocks = cus * per_cu;
        if (grid_blocks > 256) grid_blocks = 256;
        if (ws_size < W_END) fprintf(stderr, "workspace too small: %zu < %zu\n", ws_size, (size_t)W_END);
    }
    Params p{};
    const float** f = (const float**)&p;
    for (int i = 0; i < 23; ++i) f[i] = (const float*)d_in[i];
    p.out = (float*)d_out; p.ws = (unsigned char*)d_ws;
#ifndef PROBE_HI
#define PROBE_HI 9
#endif
#ifndef MK_SPLIT
#define MK_SPLIT 0
#endif
#if MK_SPLIT
    for (int k = 0; k < PROBE_HI; ++k) {
        p.phase_lo = k; p.phase_hi = k + 1;
        hipLaunchKernelGGL(hymba_fwd, dim3(grid_blocks), dim3(512), LDS_BYTES, stream, p);
    }
    if (PROBE_HI == 2) {
        hipMemcpyAsync((float*)d_out + O_SS, (unsigned char*)d_ws + W_PROJ, (size_t)64 << 20, hipMemcpyDeviceToDevice, stream);
        hipMemcpyAsync((float*)d_out + O_SP, (unsigned char*)d_ws + W_DTB, (size_t)1 << 20, hipMemcpyDeviceToDevice, stream);
    }
#else
    p.phase_lo = 0; p.phase_hi = 9;
    void* args[] = {&p};
    hipError_t e = hipLaunchCooperativeKernel((const void*)hymba_fwd, dim3(grid_blocks), dim3(512), args, LDS_BYTES, stream);
    if (e != hipSuccess) fprintf(stderr, "cooperative launch failed: %s (grid %d)\n", hipGetErrorString(e), grid_blocks);
#endif
}
```

```cpp
#include <hip/hip_runtime.h>
#include <hip/hip_cooperative_groups.h>
#include <cstdio>
namespace cg = cooperative_groups;

#define DEV __device__ __forceinline__
#define PROBE_NOMIX 0
#define LAS __attribute__((address_space(3)))
typedef unsigned short bf16_t;
typedef short bf16x8 __attribute__((ext_vector_type(8)));
typedef float f32x4 __attribute__((ext_vector_type(4)));
typedef float f32x2 __attribute__((ext_vector_type(2)));
typedef unsigned u32x2 __attribute__((ext_vector_type(2)));
typedef unsigned u32x4 __attribute__((ext_vector_type(4)));

constexpr int NP = 16384, NSMP = 128, MV = NP + NSMP, MT = 16640;
constexpr int DM = 1024, DIN = 6672, DINP = 6912, DFF = 2816, LDP = 4608, LDM = 2048;
constexpr int SEQ = 2048, NB = 8;
constexpr float EPS = 1e-6f, LOG2E = 1.4426950408889634f, LN2 = 0.6931471805599453f;
constexpr int LDS_BYTES = 131072 + 8192;

constexpr size_t O_YP = 0, O_YS = 16777216, O_HP = 16908288, O_HS = 17956864, O_SP = 34734080, O_SS = 35782656,
                 O_CSP = 52559872, O_CSS = 52596736, O_CFP = 53186560, O_CFS = 53231616;
constexpr size_t W_OUT = 0, W_UP = W_OUT + (size_t)1024 * 2048 * 2, W_DOWN = W_UP + (size_t)5632 * 1024 * 2,
                 W_SSQY = W_DOWN + (size_t)1024 * 2816 * 2, W_SSQ2 = W_SSQY + (size_t)MT * 2 * 4, W_SSQ3 = W_SSQ2 + (size_t)MT * 4,
                 W_CTR = W_SSQ3 + (size_t)MT * 4, W_LBV = W_CTR + 256, W_DTB = W_LBV + 4096, W_T = W_DTB + (size_t)MT * 16 * 4,
                 W_FG = W_T + (size_t)65 * 2 * DFF * 4, W_FV = W_FG + (size_t)65 * 2 * DFF * 4, W_BIG = ((W_FV + (size_t)65 * 2 * DFF * 4 + 4095) / 4096) * 4096,
                 W_PROJ = W_BIG, W_X1 = W_BIG, W_X1B = W_X1 + (size_t)MT * 1024 * 4, W_HMID = W_X1B + (size_t)MT * 1024 * 2,
                 W_END = W_HMID + (size_t)MT * DFF * 2, W_XC = W_PROJ + (size_t)MT * LDP * 2, W_DTV = W_XC + (size_t)NP * 1536 * 2, W_END2 = W_DTV + (size_t)NP * 16 * 2 * 4;
static_assert(W_END2 <= (size_t)256 * 1024 * 1024 && W_END <= (size_t)256 * 1024 * 1024, "workspace budget");
static_assert(W_PROJ + (size_t)MT * LDP * 2 <= W_END, "layout");

struct Params {
    const float *x_prompt, *x_sample, *st_hgrn, *st_ssm, *st_cs, *st_cf, *norm1_w, *w_in, *hgrn_lb, *hgrn_norm_w, *ssm_conv_w, *ssm_conv_b,
        *ssm_dt_bias, *ssm_a_log, *ssm_d, *ssm_norm_w, *w_out, *norm2_w, *w_up, *ffn_conv_w, *ffn_conv_b, *w_down, *final_norm_w;
    float* out; unsigned char* ws;
    int phase_lo, phase_hi;
};

DEV float bf2f(bf16_t v) { return __uint_as_float(((unsigned)v) << 16); }
typedef __bf16 bf16x2_t __attribute__((ext_vector_type(2)));
DEV unsigned cvt_pk_bf16(float lo, float hi) { f32x2 f = {lo, hi}; bf16x2_t v = __builtin_convertvector(f, bf16x2_t); return __builtin_bit_cast(unsigned, v); }
DEV bf16_t f2bf(float f) { return (bf16_t)(cvt_pk_bf16(f, 0.f) & 0xffffu); }
DEV float fexp2(float x) { return __builtin_amdgcn_exp2f(x); }
DEV float flog2(float x) { return __builtin_amdgcn_logf(x); }
DEV float frcp(float x) { return __builtin_amdgcn_rcpf(x); }
DEV float frsq(float x) { return __builtin_amdgcn_rsqf(x); }
DEV float sigmoidf_(float x) { return frcp(1.f + fexp2(-x * LOG2E)); }
DEV float siluf_(float x) { return x * sigmoidf_(x); }
DEV float softplusf_(float x) { return x > 20.f ? x : LN2 * flog2(1.f + fexp2(x * LOG2E)); }

namespace pg8 {
constexpr int BM = 256, BK = 64, HALF = 128, HTB = HALF * BK * 2, STAGE_BYTES = 8 * HTB, NXCD = 8, WGM = 8;
DEV int lds_byte(int r, int c) { const int st = (r >> 4) * 2 + (c >> 5), rr = r & 15, cc = c & 31, ob = rr * 64 + cc * 2; return st * 1024 + (ob ^ (((ob >> 9) & 1) << 5)); }
DEV void stage_rc(int b, int& R, int& C) { const int st = b / 1024, sb = b % 1024, swz = sb ^ (((sb >> 9) & 1) << 5); R = (st >> 1) * 16 + swz / 64; C = (st & 1) * 32 + (swz % 64) / 2; }
DEV int perm32(int rho) { const int n = rho >> 4, i = rho & 15; return 8 * (i >> 2) + 4 * n + (i & 3); }
struct Unit { int pm, pn; };
struct Gemm { const bf16_t* A; const bf16_t* Bt; int M, N, K; };
struct StaticOrder {
    int nM, nN, nwg, G, c;
    DEV void init(int M, int N, int G_, int c_) { nM = M / BM; nN = N / BM; nwg = nM * nN; G = G_; c = c_; }
    DEV bool next(int i, Unit& u) const {
        const long L = (long)i * G + c; if (L >= nwg) return false;
        int wgid = (int)L; { const int q = nwg / NXCD, r = nwg % NXCD, xcd = wgid % NXCD, off = wgid / NXCD; wgid = (xcd < r ? xcd * (q + 1) : r * (q + 1) + (xcd - r) * q) + off; }
        const int nig = WGM * nN, gid = wgid / nig, fm = gid * WGM, gsz = (nM - fm) < WGM ? (nM - fm) : WGM;
        u.pm = fm + ((wgid % nig) % gsz); u.pn = (wgid % nig) / gsz; return true;
    }
};

template <class Epi>
DEV void gemm_phase(LAS unsigned char* lds, const Gemm g, const StaticOrder& S, const Epi& E) {
    const int tid = threadIdx.x, wid = __builtin_amdgcn_readfirstlane(tid >> 6), lane = tid & 63, wr = wid >> 2, wc = wid & 3, fr = lane & 15, fq = lane >> 4;
    const int K = g.K, nt = K / BK;
    unsigned voffA[2], voffB[2];
#pragma unroll
    for (int i = 0; i < 2; ++i) { int R, C; stage_rc(tid * 16 + i * 8192, R, C); const int Rb = Epi::PERM ? ((R & ~31) + perm32(R & 31)) : R;
        voffA[i] = (unsigned)(R * K + C) * 2u; voffB[i] = (unsigned)(Rb * K + C) * 2u; }
    const size_t kstep = (size_t)(BK * 2);
    const size_t hstep = (size_t)HALF * K * 2;
    const size_t tstep = 2 * hstep;
    const unsigned ldsw = (unsigned)wid * 1024u;
    const int aoff = lds_byte(wr * 64 + fr, fq * 8), boff = lds_byte(wc * 32 + fr, fq * 8);
#define PG8_SA(b, h) (((b) * 2 + (h)) * HTB)
#define PG8_SB(b, h) ((4 + (b) * 2 + (h)) * HTB)
#define PG8_STAGE(bufoff, gbase, voff) do { _Pragma("unroll") for (int _i = 0; _i < 2; ++_i) \
        __builtin_amdgcn_global_load_lds((const unsigned*)((const char*)(gbase) + (voff)[_i]), (LAS unsigned*)(lds + (bufoff) + ldsw + _i * 8192), 16, 0, 0); } while (0)
#define PG8_LDA(dst, b, h) do { _Pragma("unroll") for (int m = 0; m < 4; ++m) _Pragma("unroll") for (int k = 0; k < 2; ++k) dst[m][k] = *(const LAS bf16x8*)(lds + PG8_SA(b, h) + aoff + m * 2048 + k * 1024); } while (0)
#define PG8_LDB(dst, b, h) do { _Pragma("unroll") for (int n = 0; n < 2; ++n) _Pragma("unroll") for (int k = 0; k < 2; ++k) dst[n][k] = *(const LAS bf16x8*)(lds + PG8_SB(b, h) + boff + n * 2048 + k * 1024); } while (0)
#define PG8_MMA(ai, bj, At, Bt) do { __builtin_amdgcn_s_setprio(1); _Pragma("unroll") for (int m = 0; m < 4; ++m) _Pragma("unroll") for (int n = 0; n < 2; ++n) _Pragma("unroll") for (int k = 0; k < 2; ++k) \
        acc[ai][bj][m][n] = __builtin_amdgcn_mfma_f32_16x16x32_bf16(Bt[n][k], At[m][k], acc[ai][bj][m][n], 0, 0, 0); __builtin_amdgcn_s_setprio(0); } while (0)
#define PG8_WAIT_V(n) asm volatile("s_waitcnt vmcnt(" #n ")" ::: "memory")
#define PG8_WAIT_L(n) asm volatile("s_waitcnt lgkmcnt(" #n ")" ::: "memory")
#define PG8_BAR __builtin_amdgcn_s_barrier()
#define PG8_SCHED __builtin_amdgcn_sched_barrier(0)
    Unit cur, nxt; int ui = 0;
    if (!S.next(0, cur)) return;
    f32x4 acc[2][2][4][2];
#pragma unroll
    for (int a = 0; a < 2; ++a)
#pragma unroll
        for (int b = 0; b < 2; ++b)
#pragma unroll
            for (int m = 0; m < 4; ++m)
#pragma unroll
                for (int n = 0; n < 2; ++n) acc[a][b][m][n] = (f32x4){0.f, 0.f, 0.f, 0.f};
    bf16x8 At[4][2], B0[2][2], B1[2][2];
    const char* cA = (const char*)g.A + (size_t)cur.pm * tstep; const char* cB = (const char*)g.Bt + (size_t)cur.pn * tstep;
    PG8_STAGE(PG8_SB(0, 0), cB, voffB); PG8_STAGE(PG8_SA(0, 0), cA, voffA); PG8_STAGE(PG8_SB(0, 1), cB + hstep, voffB); PG8_STAGE(PG8_SA(0, 1), cA + hstep, voffA);
    if (wr == 1) PG8_BAR;
    PG8_WAIT_V(4); PG8_BAR;
    PG8_STAGE(PG8_SB(1, 0), cB + kstep, voffB); PG8_STAGE(PG8_SA(1, 0), cA + kstep, voffA); PG8_STAGE(PG8_SB(1, 1), cB + hstep + kstep, voffB);
    PG8_WAIT_V(6); PG8_BAR;
    for (;;) {
        const bool has_next = S.next(ui + 1, nxt);
        const char* nA = has_next ? (const char*)g.A + (size_t)nxt.pm * tstep : cA; const char* nB = has_next ? (const char*)g.Bt + (size_t)nxt.pn * tstep : cB;
        for (int t = 0; t < nt; t += 2) {
            const bool last = (t == nt - 2);
            const char* a1 = cA + (size_t)(t + 1) * kstep;
            const char* a2 = last ? nA : cA + (size_t)(t + 2) * kstep; const char* b2 = last ? nB : cB + (size_t)(t + 2) * kstep;
            const char* a3 = a2 + kstep; const char* b3 = b2 + kstep;
            PG8_LDB(B0, 0, 0); PG8_SCHED; PG8_LDA(At, 0, 0); PG8_STAGE(PG8_SA(1, 1), a1 + hstep, voffA);
            PG8_WAIT_L(8); PG8_BAR; PG8_WAIT_L(0); PG8_MMA(0, 0, At, B0); PG8_BAR; PG8_SCHED;
            PG8_LDB(B1, 0, 1); PG8_STAGE(PG8_SB(0, 0), b2, voffB);
            PG8_BAR; PG8_WAIT_L(0); PG8_MMA(0, 1, At, B1); PG8_BAR;
            PG8_LDA(At, 0, 1); PG8_STAGE(PG8_SA(0, 0), a2, voffA);
            PG8_BAR; PG8_WAIT_L(0); PG8_MMA(1, 0, At, B0); PG8_BAR; PG8_SCHED;
            PG8_STAGE(PG8_SB(0, 1), b2 + hstep, voffB);
            PG8_WAIT_V(6); PG8_BAR; PG8_MMA(1, 1, At, B1); PG8_BAR;
            PG8_LDB(B0, 1, 0); PG8_SCHED; PG8_LDA(At, 1, 0); PG8_STAGE(PG8_SA(0, 1), a2 + hstep, voffA);
            PG8_WAIT_L(8); PG8_BAR; PG8_WAIT_L(0); PG8_MMA(0, 0, At, B0); PG8_BAR; PG8_SCHED;
            PG8_LDB(B1, 1, 1); PG8_STAGE(PG8_SB(1, 0), b3, voffB);
            PG8_BAR; PG8_WAIT_L(0); PG8_MMA(0, 1, At, B1); PG8_BAR;
            PG8_LDA(At, 1, 1); PG8_STAGE(PG8_SA(1, 0), a3, voffA);
            PG8_BAR; PG8_WAIT_L(0); PG8_MMA(1, 0, At, B0); PG8_BAR; PG8_SCHED;
            PG8_STAGE(PG8_SB(1, 1), b3 + hstep, voffB);
            PG8_WAIT_V(6); PG8_BAR; PG8_MMA(1, 1, At, B1); PG8_BAR;
        }
        E(acc, cur, wr, wc, fr, fq);
        if (!has_next) break;
#pragma unroll
        for (int a = 0; a < 2; ++a)
#pragma unroll
            for (int b = 0; b < 2; ++b)
#pragma unroll
                for (int m = 0; m < 4; ++m)
#pragma unroll
                    for (int n = 0; n < 2; ++n) acc[a][b][m][n] = (f32x4){0.f, 0.f, 0.f, 0.f};
        cur = nxt; cA = nA; cB = nB; ++ui;
    }
    PG8_WAIT_V(0);
    if (wr == 0) PG8_BAR;
    PG8_BAR;
#undef PG8_SA
#undef PG8_SB
#undef PG8_STAGE
#undef PG8_LDA
#undef PG8_LDB
#undef PG8_MMA
#undef PG8_WAIT_V
#undef PG8_WAIT_L
#undef PG8_BAR
#undef PG8_SCHED
}
}
using pg8::Unit;

struct EpiIn {
    static constexpr bool PERM = true;
    bf16_t* proj; bf16_t* mix; float* dtb; const float* lbv;
    DEV void operator()(const f32x4 (&acc)[2][2][4][2], const Unit& u, int wr, int wc, int fr, int fq) const {
        asm volatile("" : "+v"(fr), "+v"(fq));
#pragma unroll
        for (int bj = 0; bj < 2; ++bj) {
            const int cb = u.pn * 256 + bj * 128, c0 = cb + wc * 32 + fq * 8;
            int kind; bf16_t* dst; int ld;
            if (cb < 1024) { kind = 1; dst = proj + c0; ld = LDP; }
            else if (cb < 2048) { kind = 2; dst = proj + c0; ld = LDP; }
            else if (cb < 3072) { kind = 0; dst = proj + c0; ld = LDP; }
            else if (cb < 4096) { kind = 1; dst = mix + (c0 - 3072); ld = LDM; }
            else if (cb < 5120) { kind = 1; dst = mix + 1024 + (c0 - 4096); ld = LDM; }
            else if (cb < 6656) { kind = 0; dst = proj + 3072 + (c0 - 5120); ld = LDP; }
            else if (cb == 6656) { kind = 3; dst = nullptr; ld = 0; }
            else continue;
            f32x4 lb0 = {0.f, 0.f, 0.f, 0.f}, lb1 = {0.f, 0.f, 0.f, 0.f};
            if (kind == 2) { lb0 = *(const f32x4*)(lbv + c0 - 1024); lb1 = *(const f32x4*)(lbv + c0 - 1024 + 4); }
#pragma unroll
            for (int ai = 0; ai < 2; ++ai)
#pragma unroll
                for (int m = 0; m < 4; ++m) {
                    const int row = u.pm * 256 + ai * 128 + wr * 64 + m * 16 + fr;
                    if (row >= MV) continue;
                    f32x4 v0 = acc[ai][bj][m][0], v1 = acc[ai][bj][m][1];
                    if (kind == 3) { if (c0 < DIN) { float* d = dtb + (size_t)row * 16 + (c0 - 6656); *(f32x4*)d = v0; *(f32x4*)(d + 4) = v1; } continue; }
                    if (kind == 1) {
#pragma unroll
                        for (int j = 0; j < 4; ++j) { v0[j] = siluf_(v0[j]); v1[j] = siluf_(v1[j]); }
                    } else if (kind == 2) {
#pragma unroll
                        for (int j = 0; j < 4; ++j) { v0[j] = flog2(lb0[j] + (1.f - lb0[j]) * sigmoidf_(v0[j])); v1[j] = flog2(lb1[j] + (1.f - lb1[j]) * sigmoidf_(v1[j])); }
                    }
                    u32x4 w; w.x = cvt_pk_bf16(v0[0], v0[1]); w.y = cvt_pk_bf16(v0[2], v0[3]); w.z = cvt_pk_bf16(v1[0], v1[1]); w.w = cvt_pk_bf16(v1[2], v1[3]);
                    *(u32x4*)(dst + (size_t)row * ld) = w;
                }
        }
    }
};

struct EpiRes {
    static constexpr bool PERM = false;
    const float* r0; const float* r1;
    float* out; bf16_t* outb; float* ssq;
    DEV void operator()(const f32x4 (&acc)[2][2][4][2], const Unit& u, int wr, int wc, int fr, int fq) const {
        asm volatile("" : "+v"(fr), "+v"(fq));
        const int cbase = u.pn * 256 + wc * 32 + fq * 4;
#pragma unroll
        for (int ai = 0; ai < 2; ++ai) {
            const int rowb = u.pm * 256 + ai * 128 + wr * 64 + fr;
            f32x4 res[4][2][2];
#pragma unroll
            for (int m = 0; m < 4; ++m) {
                const int row = rowb + m * 16, rc = row < MV ? row : 0;
                const float* rr = rc < NP ? r0 + (size_t)rc * DM : r1 + (size_t)(rc - NP) * DM;
#pragma unroll
                for (int bj = 0; bj < 2; ++bj)
#pragma unroll
                    for (int n = 0; n < 2; ++n) res[m][bj][n] = *(const f32x4*)(rr + cbase + bj * 128 + n * 16);
            }
#pragma unroll
            for (int m = 0; m < 4; ++m) {
                const int row = rowb + m * 16;
                const bool ok = row < MV;
                float ss = 0.f;
#pragma unroll
                for (int bj = 0; bj < 2; ++bj)
#pragma unroll
                    for (int n = 0; n < 2; ++n) {
                        const int c = cbase + bj * 128 + n * 16;
                        const f32x4 v = res[m][bj][n] + acc[ai][bj][m][n];
                        if (ok) {
                            *(f32x4*)(out + (size_t)row * DM + c) = v;
                            if (outb) { u32x2 w; w.x = cvt_pk_bf16(v[0], v[1]); w.y = cvt_pk_bf16(v[2], v[3]); *(u32x2*)(outb + (size_t)row * DM + c) = w; }
                        }
                        ss += v[0] * v[0] + v[1] * v[1] + v[2] * v[2] + v[3] * v[3];
                    }
                ss += __shfl_xor(ss, 16); ss += __shfl_xor(ss, 32);
                if (ok && fq == 0) atomicAdd(ssq + row, ss);
            }
        }
    }
};

struct EpiUp {
    static constexpr bool PERM = true;
    bf16_t* hmid; const float* ssq2; const float* cw; const float* cbias; float* T; float* Fg; float* Fv; const float* st; float* cfp; float* cfs;
    LAS float* ex;
    DEV void operator()(const f32x4 (&acc)[2][2][4][2], const Unit& u, int wr, int wc, int fr, int fq) const {
        asm volatile("" : "+v"(fr), "+v"(fq));
        const int pm = u.pm, lane = fq * 16 + fr;
        const int chl = wc * 32 + fq * 8;
        const int ch0 = u.pn * 128 + chl;
        LAS float* RT = ex + 1024;
        if (wr == 0) { const int r = wc * 64 + lane, row = pm * 256 + r; RT[r] = row < MV ? frsq(ssq2[row] * (1.f / 1024.f) + EPS) : 0.f; }
#pragma unroll
        for (int ai = 0; ai < 2; ++ai) {
            if (fr >= 14) {
                LAS float* e = ex + ((ai * 2 + wr) * 2 + (fr - 14)) * 128 + chl;
                *(LAS f32x4*)e = acc[ai][0][3][0]; *(LAS f32x4*)(e + 4) = acc[ai][0][3][1];
            }
        }
        __syncthreads(); __syncthreads();
        const int src1 = (lane & 48) | ((fr - 1) & 15), src2 = (lane & 48) | ((fr - 2) & 15);
        if (pm < 64) {
#pragma unroll
            for (int n = 0; n < 2; ++n) {
                const int ch = ch0 + n * 4;
                const f32x4 w0 = *(const f32x4*)(cw + ch), w1 = *(const f32x4*)(cw + DFF + ch), w2 = *(const f32x4*)(cw + 2 * DFF + ch), bb = *(const f32x4*)(cbias + ch);
#pragma unroll
                for (int ai = 0; ai < 2; ++ai) {
                    f32x4 p1 = {0.f, 0.f, 0.f, 0.f}, p2 = {0.f, 0.f, 0.f, 0.f};
                    const bool has_src = (wr == 1) || (ai == 1);
                    if (has_src) {
                        const int sb = (wr == 1) ? (ai * 2 + 0) : (0 * 2 + 1);
                        const LAS float* e = ex + sb * 256 + chl + n * 4;
                        const int srow = (sb >> 1) * 128 + (sb & 1) * 64 + 62;
                        p1 = *(const LAS f32x4*)(e + 128) * RT[srow + 1];
                        p2 = *(const LAS f32x4*)(e + (fr == 0 ? 0 : 128)) * RT[srow + (fr == 0 ? 0 : 1)];
                    }
#pragma unroll
                    for (int m = 0; m < 4; ++m) {
                        const int row = pm * 256 + ai * 128 + wr * 64 + m * 16 + fr;
                        const float rs = RT[ai * 128 + wr * 64 + m * 16 + fr];
                        const f32x4 g = acc[ai][0][m][n] * rs, v = acc[ai][1][m][n] * rs;
                        f32x4 r1, r2;
#pragma unroll
                        for (int j = 0; j < 4; ++j) { r1[j] = __shfl(g[j], src1); r2[j] = __shfl(g[j], src2); }
                        const f32x4 q1 = fr >= 1 ? r1 : p1, q2 = fr >= 2 ? r2 : p2;
                        p1 = r1; p2 = r2;
                        f32x4 o;
#pragma unroll
                        for (int j = 0; j < 4; ++j) { const float cv = bb[j] + w0[j] * q2[j] + w1[j] * q1[j] + w2[j] * g[j]; o[j] = siluf_(cv) * v[j]; }
                        const bool defer = (ai == 0 && wr == 0 && m == 0 && fr < 2);
                        if (defer) {
                            *(f32x4*)(Fg + ((size_t)pm * 2 + fr) * DFF + ch) = g; *(f32x4*)(Fv + ((size_t)pm * 2 + fr) * DFF + ch) = v;
                        } else {
                            u32x2 w; w.x = cvt_pk_bf16(o[0], o[1]); w.y = cvt_pk_bf16(o[2], o[3]);
                            *(u32x2*)(hmid + (size_t)row * DFF + ch) = w;
                        }
                        if (ai == 1 && wr == 1 && m == 3 && fr >= 14) {
                            *(f32x4*)(T + ((size_t)pm * 2 + (fr - 14)) * DFF + ch) = g;
                            if ((pm & 7) == 7) *(f32x4*)(cfp + ((size_t)(pm >> 3) * 2 + (fr - 14)) * DFF + ch) = g;
                        }
                    }
                }
            }
        } else {
#pragma unroll
            for (int n = 0; n < 2; ++n) {
                const int ch = ch0 + n * 4;
                const f32x4 w0 = *(const f32x4*)(cw + ch), w1 = *(const f32x4*)(cw + DFF + ch), w2 = *(const f32x4*)(cw + 2 * DFF + ch), bb = *(const f32x4*)(cbias + ch);
#pragma unroll
                for (int m = 0; m < 4; ++m) {
                    const int b = wr * 64 + m * 16 + fr, row = NP + b;
                    const float rs = RT[b];
                    const f32x4 g = acc[0][0][m][n] * rs, v = acc[0][1][m][n] * rs;
                    const f32x4 s0 = *(const f32x4*)(st + ((size_t)b * 2 + 0) * DFF + ch), s1 = *(const f32x4*)(st + ((size_t)b * 2 + 1) * DFF + ch);
                    f32x4 o;
#pragma unroll
                    for (int j = 0; j < 4; ++j) { const float cv = bb[j] + w0[j] * s0[j] + w1[j] * s1[j] + w2[j] * g[j]; o[j] = siluf_(cv) * v[j]; }
                    u32x2 w; w.x = cvt_pk_bf16(o[0], o[1]); w.y = cvt_pk_bf16(o[2], o[3]);
                    *(u32x2*)(hmid + (size_t)row * DFF + ch) = w;
                    *(f32x4*)(cfs + ((size_t)b * 2 + 0) * DFF + ch) = s1; *(f32x4*)(cfs + ((size_t)b * 2 + 1) * DFF + ch) = g;
                }
            }
        }
    }
};

DEV void mma16(f32x4& acc, const bf16_t* A, int lda, const bf16_t* Bt, int ldb, int K, int fr, int fq) {
    const bf16_t* a = A + fr * lda + fq * 8; const bf16_t* b = Bt + fr * ldb + fq * 8;
#pragma unroll
    for (int k = 0; k < K; k += 32) {
        const bf16x8 av = *(const bf16x8*)(a + k), bv = *(const bf16x8*)(b + k);
        acc = __builtin_amdgcn_mfma_f32_16x16x32_bf16(av, bv, acc, 0, 0, 0);
    }
}

DEV void sample_gemm_res(const bf16_t* __restrict__ A, const bf16_t* __restrict__ Bt, int K, const float* __restrict__ res, float* out, bf16_t* outb, float* ssq) {
    const int wid = __builtin_amdgcn_readfirstlane(threadIdx.x >> 6), lane = threadIdx.x & 63, fr = lane & 15, fq = lane >> 4;
    for (int job = blockIdx.x * 8 + wid; job < 512; job += gridDim.x * 8) {
        const int rt = job & 7, ct = job >> 3;
        const bf16_t* a = A + (size_t)(rt * 16 + fr) * K + fq * 8; const bf16_t* b = Bt + (size_t)(ct * 16 + fr) * K + fq * 8;
        f32x4 acc = {0.f, 0.f, 0.f, 0.f};
        for (int k0 = 0; k0 < K; k0 += 256) {
            bf16x8 av[8], bv[8];
#pragma unroll
            for (int i = 0; i < 8; ++i) { av[i] = *(const bf16x8*)(a + k0 + i * 32); bv[i] = *(const bf16x8*)(b + k0 + i * 32); }
#pragma unroll
            for (int i = 0; i < 8; ++i) acc = __builtin_amdgcn_mfma_f32_16x16x32_bf16(av[i], bv[i], acc, 0, 0, 0);
        }
#pragma unroll
        for (int j = 0; j < 4; ++j) {
            const int r = rt * 16 + fq * 4 + j, c = ct * 16 + fr;
            const float v = res[(size_t)r * DM + c] + acc[j];
            out[(size_t)r * DM + c] = v;
            if (outb) outb[(size_t)r * DM + c] = f2bf(v);
            float ss = v * v; ss += __shfl_xor(ss, 1); ss += __shfl_xor(ss, 2); ss += __shfl_xor(ss, 4); ss += __shfl_xor(ss, 8);
            if (fr == 0) atomicAdd(ssq + r, ss);
        }
    }
}

DEV void transpose_weight(const float* __restrict__ src, bf16_t* __restrict__ dst, int K, int N, int Npad, int mode, const float* __restrict__ kscale, float* tile, int item) {
    constexpr int TS = 260;
    const int ntn = Npad / 256, kt = item / ntn, nt = item % ntn, k0 = kt * 64, n0 = nt * 256, tid = threadIdx.x;
    __syncthreads();
    f32x4 v[8];
#pragma unroll
    for (int i = 0; i < 8; ++i) {
        const int e = tid + i * 512, kk = e >> 6, n4 = (e & 63) * 4;
        int sc = n0 + n4;
        if (mode == 1) sc = n4 < 128 ? nt * 128 + n4 : DFF + nt * 128 + (n4 - 128);
        v[i] = (sc < N) ? *(const f32x4*)(src + (size_t)(k0 + kk) * N + sc) : (f32x4){0.f, 0.f, 0.f, 0.f};
        if (kscale) v[i] = v[i] * kscale[k0 + kk];
    }
#pragma unroll
    for (int i = 0; i < 8; ++i) { const int e = tid + i * 512, kk = e >> 6, n4 = (e & 63) * 4; *(f32x4*)(tile + kk * TS + n4) = v[i]; }
    __syncthreads();
#pragma unroll
    for (int i = 0; i < 4; ++i) {
        const int e = tid + i * 512, nn = e & 255, k8 = (e >> 8) * 8;
        u32x4 w;
        w.x = cvt_pk_bf16(tile[(k8 + 0) * TS + nn], tile[(k8 + 1) * TS + nn]); w.y = cvt_pk_bf16(tile[(k8 + 2) * TS + nn], tile[(k8 + 3) * TS + nn]);
        w.z = cvt_pk_bf16(tile[(k8 + 4) * TS + nn], tile[(k8 + 5) * TS + nn]); w.w = cvt_pk_bf16(tile[(k8 + 6) * TS + nn], tile[(k8 + 7) * TS + nn]);
        *(u32x4*)(dst + (size_t)(n0 + nn) * K + k0 + k8) = w;
    }
}

DEV void phase_prep(const Params& p, unsigned char* smem) {
    const int tid = threadIdx.x, gtid = blockIdx.x * 512 + tid, gsz = gridDim.x * 512;
    float* ssqy = (float*)(p.ws + W_SSQY);
    for (int i = gtid; i < (int)((W_LBV - W_SSQY) / 4); i += gsz) ssqy[i] = 0.f;
    float* lbv = (float*)(p.ws + W_LBV);
    for (int i = gtid; i < 1024; i += gsz) lbv[i] = sigmoidf_(p.hgrn_lb[i] - p.hgrn_lb[1024 + i]);
    bf16_t* wb_in = (bf16_t*)((unsigned char*)p.out + O_HS * 4 + (size_t)MT * 1024 * 2);
    float* tile = (float*)smem;
    const int n_in = 16 * (DINP / 256), n_out = 32 * 4, n_up = 16 * 22, n_down = 44 * 4;
    for (int it = blockIdx.x; it < n_in + n_out + n_up + n_down; it += gridDim.x) {
        if (it < n_in) transpose_weight(p.w_in, wb_in, 1024, DIN, DINP, 0, nullptr, tile, it);
        else if (it < n_in + n_out) transpose_weight(p.w_out, (bf16_t*)(p.ws + W_OUT), 2048, 1024, 1024, 0, nullptr, tile, it - n_in);
        else if (it < n_in + n_out + n_up) transpose_weight(p.w_up, (bf16_t*)(p.ws + W_UP), 1024, 5632, 5632, 1, p.norm2_w, tile, it - n_in - n_out);
        else transpose_weight(p.w_down, (bf16_t*)(p.ws + W_DOWN), 2816, 1024, 1024, 0, nullptr, tile, it - n_in - n_out - n_up);
    }
    bf16_t* h = (bf16_t*)((unsigned char*)p.out + O_HS * 4);
    const int wid = tid >> 6, lane = tid & 63;
    for (int row = blockIdx.x * 8 + wid; row < MT; row += gridDim.x * 8) {
        if (row >= MV) {
#pragma unroll
            for (int i = 0; i < 4; ++i) *(u32x2*)(h + (size_t)row * DM + i * 256 + lane * 4) = (u32x2){0u, 0u};
            continue;
        }
        const float* xr = row < NP ? p.x_prompt + (size_t)row * DM : p.x_sample + (size_t)(row - NP) * DM;
        f32x4 v[4]; float ss = 0.f;
#pragma unroll
        for (int i = 0; i < 4; ++i) { v[i] = *(const f32x4*)(xr + i * 256 + lane * 4); ss += v[i][0] * v[i][0] + v[i][1] * v[i][1] + v[i][2] * v[i][2] + v[i][3] * v[i][3]; }
#pragma unroll
        for (int o = 32; o >= 1; o >>= 1) ss += __shfl_xor(ss, o);
        const float rs = frsq(ss * (1.f / 1024.f) + EPS);
#pragma unroll
        for (int i = 0; i < 4; ++i) { const f32x4 w = *(const f32x4*)(p.norm1_w + i * 256 + lane * 4);
            u32x2 o; o.x = cvt_pk_bf16(v[i][0] * rs * w[0], v[i][1] * rs * w[1]); o.y = cvt_pk_bf16(v[i][2] * rs * w[2], v[i][3] * rs * w[3]);
            *(u32x2*)(h + (size_t)row * DM + i * 256 + lane * 4) = o; }
    }
}

#define LBAR() do { asm volatile("s_waitcnt lgkmcnt(0)" ::: "memory"); __builtin_amdgcn_s_barrier(); asm volatile("" ::: "memory"); } while (0)

DEV void phase_conv(const Params& p) {
    const bf16_t* proj = (const bf16_t*)(p.ws + W_PROJ);
    bf16_t* xc = (bf16_t*)(p.ws + W_XC);
    const int gtid = blockIdx.x * 512 + threadIdx.x, gsz = gridDim.x * 512;
    for (int it = gtid; it < 1024 * 192; it += gsz) {
        const int cg = it % 192, rb = it / 192, c0 = cg * 8, r0 = rb * 16;
        float w[4][8], bb[8], h0[8], h1[8], h2[8];
#pragma unroll
        for (int tap = 0; tap < 4; ++tap) { const f32x4 a = *(const f32x4*)(p.ssm_conv_w + tap * 1536 + c0), c = *(const f32x4*)(p.ssm_conv_w + tap * 1536 + c0 + 4);
#pragma unroll
            for (int j = 0; j < 4; ++j) { w[tap][j] = a[j]; w[tap][4 + j] = c[j]; } }
        { const f32x4 a = *(const f32x4*)(p.ssm_conv_b + c0), c = *(const f32x4*)(p.ssm_conv_b + c0 + 4);
#pragma unroll
          for (int j = 0; j < 4; ++j) { bb[j] = a[j]; bb[4 + j] = c[j]; } }
        const bool first = (r0 & (SEQ - 1)) == 0;
        const bf16_t* src = proj + (size_t)r0 * LDP + 3072 + c0;
        bf16x8 p0 = {0, 0, 0, 0, 0, 0, 0, 0}, p1 = p0, p2 = p0;
        if (!first) { p0 = *(const bf16x8*)(src - 3 * LDP); p1 = *(const bf16x8*)(src - 2 * LDP); p2 = *(const bf16x8*)(src - LDP); }
#pragma unroll
        for (int j = 0; j < 8; ++j) { h0[j] = bf2f((bf16_t)p0[j]); h1[j] = bf2f((bf16_t)p1[j]); h2[j] = bf2f((bf16_t)p2[j]); }
#pragma unroll 4
        for (int i = 0; i < 16; ++i) {
            const bf16x8 cv = *(const bf16x8*)(src + (size_t)i * LDP);
            float o[8];
#pragma unroll
            for (int j = 0; j < 8; ++j) { const float cur = bf2f((bf16_t)cv[j]); o[j] = siluf_(bb[j] + w[0][j] * h0[j] + w[1][j] * h1[j] + w[2][j] * h2[j] + w[3][j] * cur); h0[j] = h1[j]; h1[j] = h2[j]; h2[j] = cur; }
            u32x4 wv; wv.x = cvt_pk_bf16(o[0], o[1]); wv.y = cvt_pk_bf16(o[2], o[3]); wv.z = cvt_pk_bf16(o[4], o[5]); wv.w = cvt_pk_bf16(o[6], o[7]);
            *(u32x4*)(xc + (size_t)(r0 + i) * 1536 + c0) = wv;
        }
    }
    const float* dtb = (const float*)(p.ws + W_DTB); float* dtv = (float*)(p.ws + W_DTV);
    for (int i = gtid; i < NP * 16; i += gsz) { const int h = i & 15; const float dt = softplusf_(dtb[i] + p.ssm_dt_bias[h]);
        *(f32x2*)(dtv + (size_t)i * 2) = (f32x2){dt, -__expf(p.ssm_a_log[h]) * LOG2E * dt}; }
}

DEV void hgrn_prompt_item(const Params& p, int b, int hh, unsigned char* smem) {
    constexpr int LQ = 136, LS = 72;
    bf16_t* Q = (bf16_t*)smem;
    bf16_t* KT = Q + 64 * LQ;
    bf16_t* KH = KT + 64 * LQ;
    bf16_t* VT = KH + 128 * LS;
    bf16_t* PM = VT + 128 * LS;
    bf16_t* ST = PM + 64 * LS;
    bf16_t* OUT = ST + 128 * LQ;
    float* DV = (float*)(OUT + 64 * LQ);
    float* TOT = DV + 128;
    float* RS = TOT + 8 * 128;
    const int tid = threadIdx.x, wid = __builtin_amdgcn_readfirstlane(tid >> 6), lane0 = tid & 63;
    const bf16_t* proj = (const bf16_t*)(p.ws + W_PROJ);
    bf16_t* mix = (bf16_t*)p.out;
    __syncthreads();
    for (int i = tid; i < 128 * LQ / 2; i += 512) ((unsigned*)ST)[i] = 0u;
    f32x4 S[8];
#pragma unroll
    for (int i = 0; i < 8; ++i) S[i] = (f32x4){0.f, 0.f, 0.f, 0.f};
    int lane = lane0, fr = lane & 15, fq = lane >> 4;
    unsigned gq[8], qq[8]; bf16x8 va, vb; u32x4 ga[2];
#define HG_LOAD(cc) do { const size_t _r0 = (size_t)b * SEQ + (cc) * 64; \
        _Pragma("unroll") for (int i = 0; i < 8; ++i) { const bf16_t* pr = proj + (_r0 + wid * 8 + i) * LDP + hh * 128 + lane * 2; gq[i] = *(const unsigned*)(pr + 1024); qq[i] = *(const unsigned*)pr; } \
        { const bf16_t* pv = proj + (_r0 + lane) * LDP + 2048 + hh * 128 + wid * 16; va = *(const bf16x8*)pv; vb = *(const bf16x8*)(pv + 8); } \
        _Pragma("unroll") for (int i = 0; i < 2; ++i) { const int idx = tid + 512 * i; ga[i] = *(const u32x4*)(mix + (_r0 + (idx >> 4)) * LDM + hh * 128 + (idx & 15) * 8); } } while (0)
    HG_LOAD(0);
    for (int c = 0; c < 32; ++c) {
        lane = lane0; asm volatile("" : "+v"(lane));
        fr = lane & 15; fq = lane >> 4;
        const int kp = lane * 2;
        const size_t r0 = (size_t)b * SEQ + c * 64;
        float g0[8], g1[8], q0[8], q1[8], kk0[8], kk1[8];
#pragma unroll
        for (int i = 0; i < 8; ++i) {
            g0[i] = __uint_as_float(gq[i] << 16); g1[i] = __uint_as_float(gq[i] & 0xffff0000u);
            q0[i] = __uint_as_float(qq[i] << 16); q1[i] = __uint_as_float(qq[i] & 0xffff0000u);
            kk0[i] = 1.f - fexp2(g0[i]); kk1[i] = 1.f - fexp2(g1[i]);
        }
#pragma unroll
        for (int i = 1; i < 8; ++i) { g0[i] += g0[i - 1]; g1[i] += g1[i - 1]; }
        *(f32x2*)(TOT + wid * 128 + kp) = (f32x2){g0[7], g1[7]};
        {
            const int s = lane, v0 = wid * 16;
#pragma unroll
            for (int j = 0; j < 8; ++j) { VT[(v0 + j) * LS + s] = (bf16_t)va[j]; VT[(v0 + 8 + j) * LS + s] = (bf16_t)vb[j]; }
        }
        LBAR();
        if (c > 0) {
#pragma unroll
            for (int i = 0; i < 2; ++i) { const int idx = tid + 512 * i, t = idx >> 4, v8 = (idx & 15) * 8;
                *(u32x4*)(mix + (r0 - 64 + t) * LDM + hh * 128 + v8) = *(const u32x4*)(OUT + t * LQ + v8); }
        }
        {
            float pre0 = 0.f, pre1 = 0.f, tot0 = 0.f, tot1 = 0.f;
#pragma unroll
            for (int w = 0; w < 8; ++w) { const f32x2 t = *(const f32x2*)(TOT + w * 128 + kp); if (w < wid) { pre0 += t.x; pre1 += t.y; } tot0 += t.x; tot1 += t.y; }
            if (wid == 0) *(f32x2*)(DV + kp) = (f32x2){fexp2(tot0), fexp2(tot1)};
#pragma unroll
            for (int i = 0; i < 8; ++i) {
                const int t = wid * 8 + i;
                const float b0 = g0[i] + pre0, b1 = g1[i] + pre1;
                const float e0 = fexp2(b0), e1 = fexp2(b1), n0 = fexp2(-b0), n1 = fexp2(-b1), l0 = fexp2(tot0 - b0), l1 = fexp2(tot1 - b1);
                *(unsigned*)(Q + t * LQ + kp) = cvt_pk_bf16(q0[i] * e0, q1[i] * e1);
                *(unsigned*)(KT + t * LQ + kp) = cvt_pk_bf16(kk0[i] * n0, kk1[i] * n1);
                KH[kp * LS + t] = f2bf(kk0[i] * l0); KH[(kp + 1) * LS + t] = f2bf(kk1[i] * l1);
            }
        }
        LBAR();
#pragma unroll
        for (int i = 0; i < 2; ++i) { const int idx = tid + 512 * i; *(u32x4*)(OUT + (idx >> 4) * LQ + (idx & 15) * 8) = ga[i]; }
        if (c < 31) HG_LOAD(c + 1);
        {
            const int ti = wid >> 1;
#pragma unroll
            for (int x = 0; x < 2; ++x) {
                const int si = (wid & 1) * 2 + x;
                f32x4 a = {0.f, 0.f, 0.f, 0.f};
                if (si <= ti) mma16(a, Q + ti * 16 * LQ, LQ, KT + si * 16 * LQ, LQ, 128, fr, fq);
#pragma unroll
                for (int j = 0; j < 4; ++j) { const int t = ti * 16 + fq * 4 + j, s = si * 16 + fr; PM[t * LS + s] = f2bf(s <= t ? a[j] : 0.f); }
            }
        }
        f32x4 o[4];
        const int oti = wid & 3, ovb = (wid >> 2) * 4;
#pragma unroll
        for (int x = 0; x < 4; ++x) { o[x] = (f32x4){0.f, 0.f, 0.f, 0.f}; mma16(o[x], Q + oti * 16 * LQ, LQ, ST + (ovb + x) * 16 * LQ, LQ, 128, fr, fq); }
        LBAR();
        float rsum[4] = {0.f, 0.f, 0.f, 0.f};
#pragma unroll
        for (int x = 0; x < 4; ++x) { mma16(o[x], PM + oti * 16 * LS, LS, VT + (ovb + x) * 16 * LS, LS, 64, fr, fq);
#pragma unroll
            for (int j = 0; j < 4; ++j) rsum[j] += o[x][j] * o[x][j]; }
#pragma unroll
        for (int j = 0; j < 4; ++j) { float r = rsum[j]; r += __shfl_xor(r, 1); r += __shfl_xor(r, 2); r += __shfl_xor(r, 4); r += __shfl_xor(r, 8); if (fr == 0) RS[(wid >> 2) * 64 + oti * 16 + fq * 4 + j] = r; }
        {
            const f32x4 dv = *(const f32x4*)(DV + wid * 16 + fq * 4);
#pragma unroll
            for (int x = 0; x < 8; ++x) {
                S[x] = S[x] * dv;
                mma16(S[x], KH + wid * 16 * LS, LS, VT + x * 16 * LS, LS, 64, fr, fq);
                u32x2 w; w.x = cvt_pk_bf16(S[x][0], S[x][1]); w.y = cvt_pk_bf16(S[x][2], S[x][3]);
                *(u32x2*)(ST + (x * 16 + fr) * LQ + wid * 16 + fq * 4) = w;
            }
        }
        LBAR();
#pragma unroll
        for (int j = 0; j < 4; ++j) {
            const int t = oti * 16 + fq * 4 + j;
            const float rstd = frsq((RS[t] + RS[64 + t]) * (1.f / 128.f) + EPS);
#pragma unroll
            for (int x = 0; x < 4; ++x) {
                const int v = (ovb + x) * 16 + fr;
                bf16_t* op = OUT + t * LQ + v;
                *op = f2bf(o[x][j] * rstd * p.hgrn_norm_w[v] * bf2f(*op));
            }
        }
    }
#undef HG_LOAD
    LBAR();
    {
        const size_t r0 = (size_t)b * SEQ + 31 * 64;
#pragma unroll
        for (int i = 0; i < 2; ++i) { const int idx = tid + 512 * i, t = idx >> 4, v8 = (idx & 15) * 8;
            *(u32x4*)(mix + (r0 + t) * LDM + hh * 128 + v8) = *(const u32x4*)(OUT + t * LQ + v8); }
    }
    float* hp = p.out + O_HP + ((size_t)(b * 8 + hh)) * 128 * 128;
#pragma unroll
    for (int x = 0; x < 8; ++x)
#pragma unroll
        for (int j = 0; j < 4; ++j) hp[(size_t)(wid * 16 + fq * 4 + j) * 128 + x * 16 + fr] = S[x][j];
}

DEV void ssd_prompt_item(const Params& p, int b, int hh, unsigned char* smem) {
    constexpr int LN_ = 136, LS = 72;
    bf16_t* XD = (bf16_t*)smem;
    bf16_t* XE = XD + 64 * LS;
    bf16_t* XN = XE + 64 * LS;
    bf16_t* ZG = XN + 64 * LS;
    bf16_t* OUT = ZG + 64 * LS;
    bf16_t* BN = OUT + 64 * LS;
    bf16_t* BT = BN + 64 * LN_;
    bf16_t* CN = BT + 128 * LS;
    bf16_t* MM = CN + 64 * LN_;
    bf16_t* SB = MM + 64 * LS;
    float* ACS = (float*)(SB + 64 * LN_);
    const int tid = threadIdx.x, wid = __builtin_amdgcn_readfirstlane(tid >> 6), lane0 = tid & 63;
    int lane = lane0, fr = lane & 15, fq = lane >> 4;
    const int grp = hh >> 3;
    const bf16_t* proj = (const bf16_t*)(p.ws + W_PROJ);
    const bf16_t* xc = (const bf16_t*)(p.ws + W_XC);
    const float* dtv = (const float*)(p.ws + W_DTV);
    float* ssqy = (float*)(p.ws + W_SSQY);
    bf16_t* mix = (bf16_t*)p.out;
    __syncthreads();
    for (int i = tid; i < 64 * LN_ / 2; i += 512) ((unsigned*)SB)[i] = 0u;
    f32x4 S[4];
#pragma unroll
    for (int i = 0; i < 4; ++i) S[i] = (f32x4){0.f, 0.f, 0.f, 0.f};
    const float Dh = p.ssm_d[hh];
    bf16x8 xr, br[2], cr[2]; u32x4 zr; f32x2 dta;
#define SS_LOAD(cc) do { const size_t _r0 = (size_t)b * SEQ + (cc) * 64; \
        xr = *(const bf16x8*)(xc + (_r0 + (tid >> 3)) * 1536 + hh * 64 + (tid & 7) * 8); \
        zr = *(const u32x4*)(mix + (_r0 + (tid >> 3)) * LDM + 1024 + hh * 64 + (tid & 7) * 8); \
        _Pragma("unroll") for (int i = 0; i < 2; ++i) { const int idx = tid + 512 * i; const bf16_t* pb = xc + (_r0 + (idx >> 4)) * 1536 + 1024 + grp * 128 + (idx & 15) * 8; \
            br[i] = *(const bf16x8*)pb; cr[i] = *(const bf16x8*)(pb + 256); } \
        dta = *(const f32x2*)(dtv + ((_r0 + lane) * 16 + hh) * 2); } while (0)
    SS_LOAD(0);
    for (int c = 0; c < 32; ++c) {
        lane = lane0; asm volatile("" : "+v"(lane));
        fr = lane & 15; fq = lane >> 4;
        const size_t r0 = (size_t)b * SEQ + c * 64;
        const float dt = dta.x;
        float acs = dta.y;
#pragma unroll
        for (int o = 1; o < 64; o <<= 1) { const float u = __shfl_up(acs, o); if (lane >= o) acs += u; }
        const float alast = __shfl(acs, 63);
        if (wid == 0) ACS[lane] = acs;
        const float decl = fexp2(alast - acs);
        {
            const int tx = tid >> 3, p8 = (tid & 7) * 8;
            const float dtx = __shfl(dt, tx & 63), dex = __shfl(decl, tx & 63) * dtx;
            *(bf16x8*)(XN + tx * LS + p8) = xr; *(u32x4*)(ZG + tx * LS + p8) = zr;
#pragma unroll
            for (int j = 0; j < 8; ++j) { const float xv = bf2f((bf16_t)xr[j]); XD[(p8 + j) * LS + tx] = f2bf(xv * dtx); XE[(p8 + j) * LS + tx] = f2bf(xv * dex); }
#pragma unroll
            for (int i = 0; i < 2; ++i) { const int idx = tid + 512 * i, t = idx >> 4, n8 = (idx & 15) * 8;
                *(bf16x8*)(BN + t * LN_ + n8) = br[i]; *(bf16x8*)(CN + t * LN_ + n8) = cr[i];
#pragma unroll
                for (int j = 0; j < 8; ++j) BT[(n8 + j) * LS + t] = (bf16_t)br[i][j]; }
        }
        if (c < 31) SS_LOAD(c + 1);
        LBAR();
        {
            const int ti = wid >> 1;
#pragma unroll
            for (int x = 0; x < 2; ++x) {
                const int si = (wid & 1) * 2 + x;
                f32x4 a = {0.f, 0.f, 0.f, 0.f};
                if (si <= ti) mma16(a, CN + ti * 16 * LN_, LN_, BN + si * 16 * LN_, LN_, 128, fr, fq);
                const float as = ACS[si * 16 + fr];
#pragma unroll
                for (int j = 0; j < 4; ++j) { const int tt = ti * 16 + fq * 4 + j, s = si * 16 + fr; MM[tt * LS + s] = f2bf(s <= tt ? a[j] * fexp2(ACS[tt] - as) : 0.f); }
            }
        }
        f32x4 y[2];
        const int yti = wid & 3, ypb = (wid >> 2) * 2;
#pragma unroll
        for (int x = 0; x < 2; ++x) { y[x] = (f32x4){0.f, 0.f, 0.f, 0.f}; mma16(y[x], CN + yti * 16 * LN_, LN_, SB + (ypb + x) * 16 * LN_, LN_, 128, fr, fq);
#pragma unroll
            for (int j = 0; j < 4; ++j) y[x][j] *= fexp2(ACS[yti * 16 + fq * 4 + j]); }
        LBAR();
        float rsum[4] = {0.f, 0.f, 0.f, 0.f};
#pragma unroll
        for (int x = 0; x < 2; ++x) {
            mma16(y[x], MM + yti * 16 * LS, LS, XD + (ypb + x) * 16 * LS, LS, 64, fr, fq);
            const int pp = (ypb + x) * 16 + fr;
            const float wn = p.ssm_norm_w[hh * 64 + pp];
#pragma unroll
            for (int j = 0; j < 4; ++j) {
                const int tt = yti * 16 + fq * 4 + j;
                const float yv = (y[x][j] + Dh * bf2f(XN[tt * LS + pp])) * bf2f(ZG[tt * LS + pp]);
                rsum[j] += yv * yv;
                OUT[tt * LS + pp] = f2bf(yv * wn);
            }
        }
#pragma unroll
        for (int j = 0; j < 4; ++j) { float r = rsum[j]; r += __shfl_xor(r, 1); r += __shfl_xor(r, 2); r += __shfl_xor(r, 4); r += __shfl_xor(r, 8);
            if (fr == 0) atomicAdd(ssqy + (r0 + yti * 16 + fq * 4 + j) * 2 + grp, r); }
        {
            const float dl = fexp2(alast);
            const int pt = wid & 3, nb = (wid >> 2) * 4;
#pragma unroll
            for (int x = 0; x < 4; ++x) {
                S[x] = S[x] * dl;
                mma16(S[x], XE + pt * 16 * LS, LS, BT + (nb + x) * 16 * LS, LS, 64, fr, fq);
#pragma unroll
                for (int j = 0; j < 4; ++j) SB[(pt * 16 + fq * 4 + j) * LN_ + (nb + x) * 16 + fr] = f2bf(S[x][j]);
            }
        }
        LBAR();
        { const int tx = tid >> 3, p8 = (tid & 7) * 8; *(u32x4*)(mix + (r0 + tx) * LDM + 1024 + hh * 64 + p8) = *(const u32x4*)(OUT + tx * LS + p8); }
    }
#undef SS_LOAD
    {
        float* sp = p.out + O_SP + ((size_t)(b * 16 + hh)) * 64 * 128;
        const int pt = wid & 3, nb = (wid >> 2) * 4;
#pragma unroll
        for (int x = 0; x < 4; ++x)
#pragma unroll
            for (int j = 0; j < 4; ++j) sp[(size_t)(pt * 16 + fq * 4 + j) * 128 + (nb + x) * 16 + fr] = S[x][j];
    }
    if (tid < 288) { const int j = tid / 96, cc = hh * 96 + tid % 96;
        p.out[O_CSP + ((size_t)b * 3 + j) * 1536 + cc] = bf2f(proj[((size_t)b * SEQ + 2045 + j) * LDP + 3072 + cc]); }
}

DEV void hgrn_sample_item(const Params& p, int b, int hh, unsigned char* smem) {
    float* qv = (float*)smem; float* fv = qv + 128; float* kv = fv + 128; float* vv = kv + 128; float* red = vv + 128; float* sc = red + 16 * 128;
    const int tid = threadIdx.x;
    const size_t row = NP + b;
    const bf16_t* pr = (const bf16_t*)(p.ws + W_PROJ) + row * LDP + hh * 128;
    bf16_t* mix = (bf16_t*)p.out + row * LDM + hh * 128;
    __syncthreads();
    if (tid < 128) { const float f = fexp2(bf2f(pr[1024 + tid])); qv[tid] = bf2f(pr[tid]); fv[tid] = f; kv[tid] = 1.f - f; vv[tid] = bf2f(pr[2048 + tid]); }
    __syncthreads();
    const int v4 = tid & 31, kq = tid >> 5;
    const float* Sin = p.st_hgrn + ((size_t)(b * 8 + hh)) * 16384; float* Sout = p.out + O_HS + ((size_t)(b * 8 + hh)) * 16384;
    const f32x4 vx = *(const f32x4*)(vv + v4 * 4);
    f32x4 acc = {0.f, 0.f, 0.f, 0.f};
#pragma unroll
    for (int i = 0; i < 8; ++i) { const int k = kq * 8 + i; const f32x4 s = *(const f32x4*)(Sin + k * 128 + v4 * 4); const f32x4 sn = s * fv[k] + vx * kv[k];
        *(f32x4*)(Sout + k * 128 + v4 * 4) = sn; acc += sn * qv[k]; }
    *(f32x4*)(red + kq * 128 + v4 * 4) = acc;
    __syncthreads();
    float o = 0.f;
    if (tid < 128) {
#pragma unroll
        for (int i = 0; i < 16; ++i) o += red[i * 128 + tid];
        float ss = o * o;
#pragma unroll
        for (int x = 32; x >= 1; x >>= 1) ss += __shfl_xor(ss, x);
        if ((tid & 63) == 0) sc[tid >> 6] = ss;
    }
    __syncthreads();
    if (tid < 128) { const float rstd = frsq((sc[0] + sc[1]) * (1.f / 128.f) + EPS); mix[tid] = f2bf(o * rstd * p.hgrn_norm_w[tid] * bf2f(mix[tid])); }
}

DEV void ssd_sample_item(const Params& p, int b, int hh, unsigned char* smem) {
    float* xs = (float*)smem; float* Bv = xs + 64; float* Cv = Bv + 128; float* yv = Cv + 128;
    const int tid = threadIdx.x, grp = hh >> 3;
    const size_t row = NP + b;
    const bf16_t* pr = (const bf16_t*)(p.ws + W_PROJ) + row * LDP + 3072;
    const float* st = p.st_cs + (size_t)b * 3 * 1536;
    bf16_t* mix = (bf16_t*)p.out + row * LDM + 1024 + hh * 64;
    __syncthreads();
    if (tid < 320) {
        const int cc = tid < 64 ? hh * 64 + tid : (tid < 192 ? 1024 + grp * 128 + (tid - 64) : 1280 + grp * 128 + (tid - 192));
        float a = p.ssm_conv_b[cc] + p.ssm_conv_w[cc] * st[cc] + p.ssm_conv_w[1536 + cc] * st[1536 + cc] + p.ssm_conv_w[3072 + cc] * st[3072 + cc] + p.ssm_conv_w[4608 + cc] * bf2f(pr[cc]);
        a = siluf_(a);
        if (tid < 64) xs[tid] = a; else if (tid < 192) Bv[tid - 64] = a; else Cv[tid - 192] = a;
    }
    if (tid >= 384 && tid < 480) { const int cc = hh * 96 + (tid - 384);
        float* o = p.out + O_CSS + (size_t)b * 3 * 1536; o[cc] = st[1536 + cc]; o[1536 + cc] = st[3072 + cc]; o[3072 + cc] = bf2f(pr[cc]); }
    __syncthreads();
    const float dt = softplusf_(((const float*)(p.ws + W_DTB))[row * 16 + hh] + p.ssm_dt_bias[hh]);
    const float dA = __expf(-__expf(p.ssm_a_log[hh]) * dt), Dh = p.ssm_d[hh];
    const int n4 = tid & 31, pq = tid >> 5;
    const float* Sin = p.st_ssm + ((size_t)(b * 16 + hh)) * 8192; float* Sout = p.out + O_SS + ((size_t)(b * 16 + hh)) * 8192;
    const f32x4 Bx = *(const f32x4*)(Bv + n4 * 4), Cx = *(const f32x4*)(Cv + n4 * 4);
#pragma unroll
    for (int i = 0; i < 4; ++i) {
        const int pp = pq * 4 + i; const float xd = xs[pp] * dt;
        const f32x4 s = *(const f32x4*)(Sin + pp * 128 + n4 * 4); const f32x4 sn = s * dA + Bx * xd;
        *(f32x4*)(Sout + pp * 128 + n4 * 4) = sn;
        float part = sn[0] * Cx[0] + sn[1] * Cx[1] + sn[2] * Cx[2] + sn[3] * Cx[3];
#pragma unroll
        for (int x = 16; x >= 1; x >>= 1) part += __shfl_xor(part, x);
        if (n4 == 0) yv[pp] = part + Dh * xs[pp];
    }
    __syncthreads();
    if (tid < 64) {
        const float y = yv[tid] * bf2f(mix[tid]);
        float ss = y * y;
#pragma unroll
        for (int x = 32; x >= 1; x >>= 1) ss += __shfl_xor(ss, x);
        if (tid == 0) atomicAdd((float*)(p.ws + W_SSQY) + row * 2 + grp, ss);
        mix[tid] = f2bf(y * p.ssm_norm_w[hh * 64 + tid]);
    }
}

DEV void phase_scan(const Params& p, unsigned char* smem) {
#ifndef PROBE_SCAN
#define PROBE_SCAN 7
#endif
    for (int it = blockIdx.x; it < 192; it += gridDim.x) {
        if (it < 64) { if (PROBE_SCAN & 1) hgrn_prompt_item(p, it >> 3, it & 7, smem); }
        else if (PROBE_SCAN & 2) ssd_prompt_item(p, (it - 64) >> 4, (it - 64) & 15, smem);
    }
    if (!(PROBE_SCAN & 4)) return;
    unsigned* ctr = (unsigned*)(p.ws + W_CTR);
    LAS unsigned* slot = (LAS unsigned*)(smem + LDS_BYTES - 16);
    for (;;) {
        __syncthreads();
        if (threadIdx.x == 0) *slot = atomicAdd(ctr, 1u);
        __syncthreads();
        const unsigned j = *slot;
        if (j >= 3072u) break;
        if (j < 1024u) hgrn_sample_item(p, j >> 3, j & 7, smem);
        else ssd_sample_item(p, (j - 1024u) >> 4, (j - 1024u) & 15, smem);
    }
}

DEV void phase_yscale(const Params& p) {
    bf16_t* mix = (bf16_t*)p.out; const float* ssqy = (const float*)(p.ws + W_SSQY);
    for (int i = blockIdx.x * 512 + threadIdx.x; i < MV * 128; i += gridDim.x * 512) {
        const int row = i >> 7, c8 = i & 127;
        const float rs = frsq(ssqy[row * 2 + (c8 >> 6)] * (1.f / 512.f) + EPS);
        u32x4* ptr = (u32x4*)(mix + (size_t)row * LDM + 1024 + c8 * 8);
        u32x4 w = *ptr;
        unsigned* ww = (unsigned*)&w;
#pragma unroll
        for (int j = 0; j < 4; ++j) ww[j] = cvt_pk_bf16(__uint_as_float(ww[j] << 16) * rs, __uint_as_float(ww[j] & 0xffff0000u) * rs);
        *ptr = w;
    }
}

DEV void fix_hmid_rows(const Params& p, int pm) {
    const float* T = (const float*)(p.ws + W_T); const float* Fg = (const float*)(p.ws + W_FG); const float* Fv = (const float*)(p.ws + W_FV);
    bf16_t* hmid = (bf16_t*)(p.ws + W_HMID);
    for (int ch = threadIdx.x; ch < DFF; ch += 512) {
        const bool first = (pm & 7) == 0;
        const float gm2 = first ? 0.f : T[((size_t)(pm - 1) * 2 + 0) * DFF + ch], gm1 = first ? 0.f : T[((size_t)(pm - 1) * 2 + 1) * DFF + ch];
        const float G0 = Fg[((size_t)pm * 2 + 0) * DFF + ch], G1 = Fg[((size_t)pm * 2 + 1) * DFF + ch];
        const float v0 = Fv[((size_t)pm * 2 + 0) * DFF + ch], v1 = Fv[((size_t)pm * 2 + 1) * DFF + ch];
        const float w0 = p.ffn_conv_w[ch], w1 = p.ffn_conv_w[DFF + ch], w2 = p.ffn_conv_w[2 * DFF + ch], bb = p.ffn_conv_b[ch];
        hmid[(size_t)(pm * 256) * DFF + ch] = f2bf(siluf_(bb + w0 * gm2 + w1 * gm1 + w2 * G0) * v0);
        hmid[(size_t)(pm * 256 + 1) * DFF + ch] = f2bf(siluf_(bb + w0 * gm1 + w1 * G0 + w2 * G1) * v1);
    }
}

DEV void phase_final(const Params& p) {
    const float* ssq3 = (const float*)(p.ws + W_SSQ3);
    const int wid = threadIdx.x >> 6, lane = threadIdx.x & 63;
    for (int row = blockIdx.x * 8 + wid; row < MV; row += gridDim.x * 8) {
        const float rs = frsq(ssq3[row] * (1.f / 1024.f) + EPS);
        float* yr = p.out + (size_t)row * DM;
#pragma unroll
        for (int i = 0; i < 4; ++i) { const int c = i * 256 + lane * 4; const f32x4 w = *(const f32x4*)(p.final_norm_w + c); f32x4 v = *(const f32x4*)(yr + c);
            v = v * w * rs; *(f32x4*)(yr + c) = v; }
    }
}

__global__ void __launch_bounds__(512, 2) hymba_fwd(Params p) {
    extern __shared__ __attribute__((aligned(16))) unsigned char smem[];
    cg::grid_group grid = cg::this_grid();
    LAS unsigned char* lds = (LAS unsigned char*)smem;
    bf16_t* h = (bf16_t*)((unsigned char*)p.out + O_HS * 4);
    bf16_t* wb_in = h + (size_t)MT * 1024;
    bf16_t* mix = (bf16_t*)p.out;
#define PHASE_BEGIN(k) if (p.phase_lo <= (k) && (k) < p.phase_hi) { if ((k) != p.phase_lo) grid.sync();
#define PHASE_END }
    PHASE_BEGIN(0) phase_prep(p, smem); PHASE_END
    PHASE_BEGIN(1)
        pg8::StaticOrder S; S.init(MT, DINP, gridDim.x, blockIdx.x);
        EpiIn E{(bf16_t*)(p.ws + W_PROJ), mix, (float*)(p.ws + W_DTB), (const float*)(p.ws + W_LBV)};
        pg8::gemm_phase(lds, pg8::Gemm{h, wb_in, MT, DINP, 1024}, S, E);
    PHASE_END
    PHASE_BEGIN(2) phase_conv(p); PHASE_END
    PHASE_BEGIN(3) phase_scan(p, smem); PHASE_END
    PHASE_BEGIN(4) phase_yscale(p); PHASE_END
    PHASE_BEGIN(5)
        pg8::StaticOrder S; S.init(NP, 1024, gridDim.x, blockIdx.x);
        EpiRes E{p.x_prompt, p.x_sample, (float*)(p.ws + W_X1), (bf16_t*)(p.ws + W_X1B), (float*)(p.ws + W_SSQ2)};
        pg8::gemm_phase(lds, pg8::Gemm{mix, (const bf16_t*)(p.ws + W_OUT), NP, 1024, 2048}, S, E);
        sample_gemm_res(mix + (size_t)NP * LDM, (const bf16_t*)(p.ws + W_OUT), 2048, p.x_sample, (float*)(p.ws + W_X1) + (size_t)NP * DM,
                        (bf16_t*)(p.ws + W_X1B) + (size_t)NP * DM, (float*)(p.ws + W_SSQ2) + NP);
    PHASE_END
    PHASE_BEGIN(6)
        pg8::StaticOrder S; S.init(MT, 5632, gridDim.x, blockIdx.x);
        EpiUp E{(bf16_t*)(p.ws + W_HMID), (const float*)(p.ws + W_SSQ2), p.ffn_conv_w, p.ffn_conv_b, (float*)(p.ws + W_T), (float*)(p.ws + W_FG), (float*)(p.ws + W_FV),
                p.st_cf, p.out + O_CFP, p.out + O_CFS, (LAS float*)(lds + 131072)};
        pg8::gemm_phase(lds, pg8::Gemm{(const bf16_t*)(p.ws + W_X1B), (const bf16_t*)(p.ws + W_UP), MT, 5632, 1024}, S, E);
    PHASE_END
    PHASE_BEGIN(7) for (int pm = blockIdx.x; pm < 64; pm += gridDim.x) fix_hmid_rows(p, pm); PHASE_END
    PHASE_BEGIN(8)
        pg8::StaticOrder S; S.init(NP, 1024, gridDim.x, blockIdx.x);
        const float* x1 = (const float*)(p.ws + W_X1);
        EpiRes E{x1, x1 + (size_t)NP * DM, p.out, nullptr, (float*)(p.ws + W_SSQ3)};
        pg8::gemm_phase(lds, pg8::Gemm{(const bf16_t*)(p.ws + W_HMID), (const bf16_t*)(p.ws + W_DOWN), NP, 1024, DFF}, S, E);
        sample_gemm_res((const bf16_t*)(p.ws + W_HMID) + (size_t)NP * DFF, (const bf16_t*)(p.ws + W_DOWN), DFF, x1 + (size_t)NP * DM, p.out + (size_t)NP * DM,
                        nullptr, (float*)(p.ws + W_SSQ3) + NP);
    PHASE_END
    PHASE_BEGIN(9) phase_final(p); PHASE_END
}

extern "C" void kernel_launch(void* const* d_in, const int* in_sizes, int n_in, void* d_out, int out_size, void* d_ws, size_t ws_size, hipStream_t stream) {
    static int grid_blocks = 0;
    if (!grid_blocks) {
        int dev = 0, cus = 0, per_cu = 0;
        hipGetDevice(&dev);
        hipDeviceGetAttribute(&cus, hipDeviceAttributeMultiprocessorCount, dev);
        hipFuncSetAttribute((const void*)hymba_fwd, hipFuncAttributeMaxDynamicSharedMemorySize, LDS_BYTES);
        hipOccupancyMaxActiveBlocksPerMultiprocessor(&per_cu, hymba_fwd, 512, LDS_BYTES);
        if (per_cu < 1) per_cu = 1;
        grid_blocks = cus * per_cu;
        if (grid_blocks > 256) grid_blocks = 256;
        if (ws_size < W_END) fprintf(stderr, "workspace too small: %zu < %zu\n", ws_size, (size_t)W_END);
    }
    Params p{};
    const float** f = (const float**)&p;
    for (int i = 0; i < 23; ++i) f[i] = (const float*)d_in[i];
    p.out = (float*)d_out; p.ws = (unsigned char*)d_ws;
#ifndef PROBE_HI
#define PROBE_HI 10
#endif
#ifndef MK_SPLIT
#define MK_SPLIT 0
#endif
#if MK_SPLIT
    for (int k = 0; k < PROBE_HI; ++k) {
        p.phase_lo = k; p.phase_hi = k + 1;
        hipLaunchKernelGGL(hymba_fwd, dim3(grid_blocks), dim3(512), LDS_BYTES, stream, p);
    }
    if (PROBE_HI == 2) {
        hipMemcpyAsync((float*)d_out + O_SS, (unsigned char*)d_ws + W_PROJ, (size_t)64 << 20, hipMemcpyDeviceToDevice, stream);
        hipMemcpyAsync((float*)d_out + O_SP, (unsigned char*)d_ws + W_DTB, (size_t)1 << 20, hipMemcpyDeviceToDevice, stream);
    }
#else
    p.phase_lo = 0; p.phase_hi = 10;
    void* args[] = {&p};
    hipError_t e = hipLaunchCooperativeKernel((const void*)hymba_fwd, dim3(grid_blocks), dim3(512), args, LDS_BYTES, stream);
    if (e != hipSuccess) fprintf(stderr, "cooperative launch failed: %s (grid %d)\n", hipGetErrorString(e), grid_blocks);
#endif
}
```

```cpp
#include <hip/hip_runtime.h>
#include <hip/hip_cooperative_groups.h>
#include <cstdio>
namespace cg = cooperative_groups;

#define DEV __device__ __forceinline__
#define PROBE_NOMIX 0
#define LAS __attribute__((address_space(3)))
typedef unsigned short bf16_t;
typedef short bf16x8 __attribute__((ext_vector_type(8)));
typedef float f32x4 __attribute__((ext_vector_type(4)));
typedef float f32x2 __attribute__((ext_vector_type(2)));
typedef unsigned u32x2 __attribute__((ext_vector_type(2)));
typedef unsigned u32x4 __attribute__((ext_vector_type(4)));

constexpr int NP = 16384, NSMP = 128, MV = NP + NSMP, MT = 16640;
constexpr int DM = 1024, DIN = 6672, DINP = 6912, DFF = 2816, LDP = 4608, LDM = 2048;
constexpr int SEQ = 2048, NB = 8;
constexpr float EPS = 1e-6f, LOG2E = 1.4426950408889634f, LN2 = 0.6931471805599453f;
constexpr int LDS_BYTES = 131072 + 8192;

constexpr size_t O_YP = 0, O_YS = 16777216, O_HP = 16908288, O_HS = 17956864, O_SP = 34734080, O_SS = 35782656,
                 O_CSP = 52559872, O_CSS = 52596736, O_CFP = 53186560, O_CFS = 53231616;
constexpr size_t W_OUT = 0, W_UP = W_OUT + (size_t)1024 * 2048 * 2, W_DOWN = W_UP + (size_t)5632 * 1024 * 2,
                 W_SSQY = W_DOWN + (size_t)1024 * 2816 * 2, W_SSQ2 = W_SSQY + (size_t)MT * 2 * 4, W_SSQ3 = W_SSQ2 + (size_t)MT * 4,
                 W_CTR = W_SSQ3 + (size_t)MT * 4, W_LBV = W_CTR + 256, W_DTB = W_LBV + 4096, W_T = W_DTB + (size_t)MT * 16 * 4,
                 W_FG = W_T + (size_t)65 * 2 * DFF * 4, W_FV = W_FG + (size_t)65 * 2 * DFF * 4, W_BIG = ((W_FV + (size_t)65 * 2 * DFF * 4 + 4095) / 4096) * 4096,
                 W_PROJ = W_BIG, W_X1 = W_BIG, W_X1B = W_X1 + (size_t)MT * 1024 * 4, W_HMID = W_X1B + (size_t)MT * 1024 * 2,
                 W_END = W_HMID + (size_t)MT * DFF * 2, W_XC = W_PROJ + (size_t)MT * LDP * 2, W_DTV = W_XC + (size_t)NP * 1536 * 2, W_END2 = W_DTV + (size_t)NP * 16 * 2 * 4;
static_assert(W_END2 <= (size_t)256 * 1024 * 1024 && W_END <= (size_t)256 * 1024 * 1024, "workspace budget");
static_assert(W_PROJ + (size_t)MT * LDP * 2 <= W_END, "layout");

struct Params {
    const float *x_prompt, *x_sample, *st_hgrn, *st_ssm, *st_cs, *st_cf, *norm1_w, *w_in, *hgrn_lb, *hgrn_norm_w, *ssm_conv_w, *ssm_conv_b,
        *ssm_dt_bias, *ssm_a_log, *ssm_d, *ssm_norm_w, *w_out, *norm2_w, *w_up, *ffn_conv_w, *ffn_conv_b, *w_down, *final_norm_w;
    float* out; unsigned char* ws;
    int phase_lo, phase_hi;
};

DEV float bf2f(bf16_t v) { return __uint_as_float(((unsigned)v) << 16); }
typedef __bf16 bf16x2_t __attribute__((ext_vector_type(2)));
DEV unsigned cvt_pk_bf16(float lo, float hi) { f32x2 f = {lo, hi}; bf16x2_t v = __builtin_convertvector(f, bf16x2_t); return __builtin_bit_cast(unsigned, v); }
DEV bf16_t f2bf(float f) { return (bf16_t)(cvt_pk_bf16(f, 0.f) & 0xffffu); }
DEV float fexp2(float x) { return __builtin_amdgcn_exp2f(x); }
DEV float flog2(float x) { return __builtin_amdgcn_logf(x); }
DEV float frcp(float x) { return __builtin_amdgcn_rcpf(x); }
DEV float frsq(float x) { return __builtin_amdgcn_rsqf(x); }
DEV float sigmoidf_(float x) { return frcp(1.f + fexp2(-x * LOG2E)); }
DEV float siluf_(float x) { return x * sigmoidf_(x); }
DEV float softplusf_(float x) { return x > 20.f ? x : LN2 * flog2(1.f + fexp2(x * LOG2E)); }

namespace pg8 {
constexpr int BM = 256, BK = 64, HALF = 128, HTB = HALF * BK * 2, STAGE_BYTES = 8 * HTB, NXCD = 8, WGM = 8;
DEV int lds_byte(int r, int c) { const int st = (r >> 4) * 2 + (c >> 5), rr = r & 15, cc = c & 31, ob = rr * 64 + cc * 2; return st * 1024 + (ob ^ (((ob >> 9) & 1) << 5)); }
DEV void stage_rc(int b, int& R, int& C) { const int st = b / 1024, sb = b % 1024, swz = sb ^ (((sb >> 9) & 1) << 5); R = (st >> 1) * 16 + swz / 64; C = (st & 1) * 32 + (swz % 64) / 2; }
DEV int perm32(int rho) { const int n = rho >> 4, i = rho & 15; return 8 * (i >> 2) + 4 * n + (i & 3); }
struct Unit { int pm, pn; };
struct Gemm { const bf16_t* A; const bf16_t* Bt; int M, N, K; };
struct StaticOrder {
    int nM, nN, nwg, G, c;
    DEV void init(int M, int N, int G_, int c_) { nM = M / BM; nN = N / BM; nwg = nM * nN; G = G_; c = c_; }
    DEV bool next(int i, Unit& u) const {
        const long L = (long)i * G + c; if (L >= nwg) return false;
        int wgid = (int)L; { const int q = nwg / NXCD, r = nwg % NXCD, xcd = wgid % NXCD, off = wgid / NXCD; wgid = (xcd < r ? xcd * (q + 1) : r * (q + 1) + (xcd - r) * q) + off; }
        const int nig = WGM * nN, gid = wgid / nig, fm = gid * WGM, gsz = (nM - fm) < WGM ? (nM - fm) : WGM;
        u.pm = fm + ((wgid % nig) % gsz); u.pn = (wgid % nig) / gsz; return true;
    }
};

template <class Epi>
DEV void gemm_phase(LAS unsigned char* lds, const Gemm g, const StaticOrder& S, const Epi& E) {
    const int tid = threadIdx.x, wid = __builtin_amdgcn_readfirstlane(tid >> 6), lane = tid & 63, wr = wid >> 2, wc = wid & 3, fr = lane & 15, fq = lane >> 4;
    const int K = g.K, nt = K / BK;
    unsigned voffA[2], voffB[2];
#pragma unroll
    for (int i = 0; i < 2; ++i) { int R, C; stage_rc(tid * 16 + i * 8192, R, C); const int Rb = Epi::PERM ? ((R & ~31) + perm32(R & 31)) : R;
        voffA[i] = (unsigned)(R * K + C) * 2u; voffB[i] = (unsigned)(Rb * K + C) * 2u; }
    const size_t kstep = (size_t)(BK * 2);
    const size_t hstep = (size_t)HALF * K * 2;
    const size_t tstep = 2 * hstep;
    const unsigned ldsw = (unsigned)wid * 1024u;
    const int aoff = lds_byte(wr * 64 + fr, fq * 8), boff = lds_byte(wc * 32 + fr, fq * 8);
#define PG8_SA(b, h) (((b) * 2 + (h)) * HTB)
#define PG8_SB(b, h) ((4 + (b) * 2 + (h)) * HTB)
#define PG8_STAGE(bufoff, gbase, voff) do { _Pragma("unroll") for (int _i = 0; _i < 2; ++_i) \
        __builtin_amdgcn_global_load_lds((const unsigned*)((const char*)(gbase) + (voff)[_i]), (LAS unsigned*)(lds + (bufoff) + ldsw + _i * 8192), 16, 0, 0); } while (0)
#define PG8_LDA(dst, b, h) do { _Pragma("unroll") for (int m = 0; m < 4; ++m) _Pragma("unroll") for (int k = 0; k < 2; ++k) dst[m][k] = *(const LAS bf16x8*)(lds + PG8_SA(b, h) + aoff + m * 2048 + k * 1024); } while (0)
#define PG8_LDB(dst, b, h) do { _Pragma("unroll") for (int n = 0; n < 2; ++n) _Pragma("unroll") for (int k = 0; k < 2; ++k) dst[n][k] = *(const LAS bf16x8*)(lds + PG8_SB(b, h) + boff + n * 2048 + k * 1024); } while (0)
#define PG8_MMA(ai, bj, At, Bt) do { __builtin_amdgcn_s_setprio(1); _Pragma("unroll") for (int m = 0; m < 4; ++m) _Pragma("unroll") for (int n = 0; n < 2; ++n) _Pragma("unroll") for (int k = 0; k < 2; ++k) \
        acc[ai][bj][m][n] = __builtin_amdgcn_mfma_f32_16x16x32_bf16(Bt[n][k], At[m][k], acc[ai][bj][m][n], 0, 0, 0); __builtin_amdgcn_s_setprio(0); } while (0)
#define PG8_WAIT_V(n) asm volatile("s_waitcnt vmcnt(" #n ")" ::: "memory")
#define PG8_WAIT_L(n) asm volatile("s_waitcnt lgkmcnt(" #n ")" ::: "memory")
#define PG8_BAR __builtin_amdgcn_s_barrier()
#define PG8_SCHED __builtin_amdgcn_sched_barrier(0)
    Unit cur, nxt; int ui = 0;
    if (!S.next(0, cur)) return;
    f32x4 acc[2][2][4][2];
#pragma unroll
    for (int a = 0; a < 2; ++a)
#pragma unroll
        for (int b = 0; b < 2; ++b)
#pragma unroll
            for (int m = 0; m < 4; ++m)
#pragma unroll
                for (int n = 0; n < 2; ++n) acc[a][b][m][n] = (f32x4){0.f, 0.f, 0.f, 0.f};
    bf16x8 At[4][2], B0[2][2], B1[2][2];
    const char* cA = (const char*)g.A + (size_t)cur.pm * tstep; const char* cB = (const char*)g.Bt + (size_t)cur.pn * tstep;
    PG8_STAGE(PG8_SB(0, 0), cB, voffB); PG8_STAGE(PG8_SA(0, 0), cA, voffA); PG8_STAGE(PG8_SB(0, 1), cB + hstep, voffB); PG8_STAGE(PG8_SA(0, 1), cA + hstep, voffA);
    if (wr == 1) PG8_BAR;
    PG8_WAIT_V(4); PG8_BAR;
    PG8_STAGE(PG8_SB(1, 0), cB + kstep, voffB); PG8_STAGE(PG8_SA(1, 0), cA + kstep, voffA); PG8_STAGE(PG8_SB(1, 1), cB + hstep + kstep, voffB);
    PG8_WAIT_V(6); PG8_BAR;
    for (;;) {
        const bool has_next = S.next(ui + 1, nxt);
        const char* nA = has_next ? (const char*)g.A + (size_t)nxt.pm * tstep : cA; const char* nB = has_next ? (const char*)g.Bt + (size_t)nxt.pn * tstep : cB;
        for (int t = 0; t < nt; t += 2) {
            const bool last = (t == nt - 2);
            const char* a1 = cA + (size_t)(t + 1) * kstep;
            const char* a2 = last ? nA : cA + (size_t)(t + 2) * kstep; const char* b2 = last ? nB : cB + (size_t)(t + 2) * kstep;
            const char* a3 = a2 + kstep; const char* b3 = b2 + kstep;
            PG8_LDB(B0, 0, 0); PG8_SCHED; PG8_LDA(At, 0, 0); PG8_STAGE(PG8_SA(1, 1), a1 + hstep, voffA);
            PG8_WAIT_L(8); PG8_BAR; PG8_WAIT_L(0); PG8_MMA(0, 0, At, B0); PG8_BAR; PG8_SCHED;
            PG8_LDB(B1, 0, 1); PG8_STAGE(PG8_SB(0, 0), b2, voffB);
            PG8_BAR; PG8_WAIT_L(0); PG8_MMA(0, 1, At, B1); PG8_BAR;
            PG8_LDA(At, 0, 1); PG8_STAGE(PG8_SA(0, 0), a2, voffA);
            PG8_BAR; PG8_WAIT_L(0); PG8_MMA(1, 0, At, B0); PG8_BAR; PG8_SCHED;
            PG8_STAGE(PG8_SB(0, 1), b2 + hstep, voffB);
            PG8_WAIT_V(6); PG8_BAR; PG8_MMA(1, 1, At, B1); PG8_BAR;
            PG8_LDB(B0, 1, 0); PG8_SCHED; PG8_LDA(At, 1, 0); PG8_STAGE(PG8_SA(0, 1), a2 + hstep, voffA);
            PG8_WAIT_L(8); PG8_BAR; PG8_WAIT_L(0); PG8_MMA(0, 0, At, B0); PG8_BAR; PG8_SCHED;
            PG8_LDB(B1, 1, 1); PG8_STAGE(PG8_SB(1, 0), b3, voffB);
            PG8_BAR; PG8_WAIT_L(0); PG8_MMA(0, 1, At, B1); PG8_BAR;
            PG8_LDA(At, 1, 1); PG8_STAGE(PG8_SA(1, 0), a3, voffA);
            PG8_BAR; PG8_WAIT_L(0); PG8_MMA(1, 0, At, B0); PG8_BAR; PG8_SCHED;
            PG8_STAGE(PG8_SB(1, 1), b3 + hstep, voffB);
            PG8_WAIT_V(6); PG8_BAR; PG8_MMA(1, 1, At, B1); PG8_BAR;
        }
        E(acc, cur, wr, wc, fr, fq);
        if (!has_next) break;
#pragma unroll
        for (int a = 0; a < 2; ++a)
#pragma unroll
            for (int b = 0; b < 2; ++b)
#pragma unroll
                for (int m = 0; m < 4; ++m)
#pragma unroll
                    for (int n = 0; n < 2; ++n) acc[a][b][m][n] = (f32x4){0.f, 0.f, 0.f, 0.f};
        cur = nxt; cA = nA; cB = nB; ++ui;
    }
    PG8_WAIT_V(0);
    if (wr == 0) PG8_BAR;
    PG8_BAR;
#undef PG8_SA
#undef PG8_SB
#undef PG8_STAGE
#undef PG8_LDA
#undef PG8_LDB
#undef PG8_MMA
#undef PG8_WAIT_V
#undef PG8_WAIT_L
#undef PG8_BAR
#undef PG8_SCHED
}
}
using pg8::Unit;

struct EpiIn {
    static constexpr bool PERM = true;
    bf16_t* proj; bf16_t* mix; float* dtb; const float* lbv;
    DEV void operator()(const f32x4 (&acc)[2][2][4][2], const Unit& u, int wr, int wc, int fr, int fq) const {
        asm volatile("" : "+v"(fr), "+v"(fq));
#pragma unroll
        for (int bj = 0; bj < 2; ++bj) {
            const int cb = u.pn * 256 + bj * 128, c0 = cb + wc * 32 + fq * 8;
            int kind; bf16_t* dst; int ld;
            if (cb < 1024) { kind = 1; dst = proj + c0; ld = LDP; }
            else if (cb < 2048) { kind = 2; dst = proj + c0; ld = LDP; }
            else if (cb < 3072) { kind = 0; dst = proj + c0; ld = LDP; }
            else if (cb < 4096) { kind = 1; dst = mix + (c0 - 3072); ld = LDM; }
            else if (cb < 5120) { kind = 1; dst = mix + 1024 + (c0 - 4096); ld = LDM; }
            else if (cb < 6656) { kind = 0; dst = proj + 3072 + (c0 - 5120); ld = LDP; }
            else if (cb == 6656) { kind = 3; dst = nullptr; ld = 0; }
            else continue;
            f32x4 lb0 = {0.f, 0.f, 0.f, 0.f}, lb1 = {0.f, 0.f, 0.f, 0.f};
            if (kind == 2) { lb0 = *(const f32x4*)(lbv + c0 - 1024); lb1 = *(const f32x4*)(lbv + c0 - 1024 + 4); }
#pragma unroll
            for (int ai = 0; ai < 2; ++ai)
#pragma unroll
                for (int m = 0; m < 4; ++m) {
                    const int row = u.pm * 256 + ai * 128 + wr * 64 + m * 16 + fr;
                    if (row >= MV) continue;
                    f32x4 v0 = acc[ai][bj][m][0], v1 = acc[ai][bj][m][1];
                    if (kind == 3) { if (c0 < DIN) { float* d = dtb + (size_t)row * 16 + (c0 - 6656); *(f32x4*)d = v0; *(f32x4*)(d + 4) = v1; } continue; }
                    if (kind == 1) {
#pragma unroll
                        for (int j = 0; j < 4; ++j) { v0[j] = siluf_(v0[j]); v1[j] = siluf_(v1[j]); }
                    } else if (kind == 2) {
#pragma unroll
                        for (int j = 0; j < 4; ++j) { v0[j] = flog2(lb0[j] + (1.f - lb0[j]) * sigmoidf_(v0[j])); v1[j] = flog2(lb1[j] + (1.f - lb1[j]) * sigmoidf_(v1[j])); }
                    }
                    u32x4 w; w.x = cvt_pk_bf16(v0[0], v0[1]); w.y = cvt_pk_bf16(v0[2], v0[3]); w.z = cvt_pk_bf16(v1[0], v1[1]); w.w = cvt_pk_bf16(v1[2], v1[3]);
                    *(u32x4*)(dst + (size_t)row * ld) = w;
                }
        }
    }
};

struct EpiRes {
    static constexpr bool PERM = false;
    const float* r0; const float* r1;
    float* out; bf16_t* outb; float* ssq;
    DEV void operator()(const f32x4 (&acc)[2][2][4][2], const Unit& u, int wr, int wc, int fr, int fq) const {
        asm volatile("" : "+v"(fr), "+v"(fq));
        const int cbase = u.pn * 256 + wc * 32 + fq * 4;
#pragma unroll
        for (int ai = 0; ai < 2; ++ai) {
            const int rowb = u.pm * 256 + ai * 128 + wr * 64 + fr;
            f32x4 res[4][2][2];
#pragma unroll
            for (int m = 0; m < 4; ++m) {
                const int row = rowb + m * 16, rc = row < MV ? row : 0;
                const float* rr = rc < NP ? r0 + (size_t)rc * DM : r1 + (size_t)(rc - NP) * DM;
#pragma unroll
                for (int bj = 0; bj < 2; ++bj)
#pragma unroll
                    for (int n = 0; n < 2; ++n) res[m][bj][n] = *(const f32x4*)(rr + cbase + bj * 128 + n * 16);
            }
#pragma unroll
            for (int m = 0; m < 4; ++m) {
                const int row = rowb + m * 16;
                const bool ok = row < MV;
                float ss = 0.f;
#pragma unroll
                for (int bj = 0; bj < 2; ++bj)
#pragma unroll
                    for (int n = 0; n < 2; ++n) {
                        const int c = cbase + bj * 128 + n * 16;
                        const f32x4 v = res[m][bj][n] + acc[ai][bj][m][n];
                        if (ok) {
                            *(f32x4*)(out + (size_t)row * DM + c) = v;
                            if (outb) { u32x2 w; w.x = cvt_pk_bf16(v[0], v[1]); w.y = cvt_pk_bf16(v[2], v[3]); *(u32x2*)(outb + (size_t)row * DM + c) = w; }
                        }
                        ss += v[0] * v[0] + v[1] * v[1] + v[2] * v[2] + v[3] * v[3];
                    }
                ss += __shfl_xor(ss, 16); ss += __shfl_xor(ss, 32);
                if (ok && fq == 0) atomicAdd(ssq + row, ss);
            }
        }
    }
};

struct EpiUp {
    static constexpr bool PERM = true;
    bf16_t* hmid; const float* ssq2; const float* cw; const float* cbias; float* T; float* Fg; float* Fv; const float* st; float* cfp; float* cfs;
    LAS float* ex;
    DEV void operator()(const f32x4 (&acc)[2][2][4][2], const Unit& u, int wr, int wc, int fr, int fq) const {
        asm volatile("" : "+v"(fr), "+v"(fq));
        const int pm = u.pm, lane = fq * 16 + fr;
        const int chl = wc * 32 + fq * 8;
        const int ch0 = u.pn * 128 + chl;
        LAS float* RT = ex + 1024;
        if (wr == 0) { const int r = wc * 64 + lane, row = pm * 256 + r; RT[r] = row < MV ? frsq(ssq2[row] * (1.f / 1024.f) + EPS) : 0.f; }
#pragma unroll
        for (int ai = 0; ai < 2; ++ai) {
            if (fr >= 14) {
                LAS float* e = ex + ((ai * 2 + wr) * 2 + (fr - 14)) * 128 + chl;
                *(LAS f32x4*)e = acc[ai][0][3][0]; *(LAS f32x4*)(e + 4) = acc[ai][0][3][1];
            }
        }
        __syncthreads(); __syncthreads();
        const int src1 = (lane & 48) | ((fr - 1) & 15), src2 = (lane & 48) | ((fr - 2) & 15);
        if (pm < 64) {
#pragma unroll
            for (int n = 0; n < 2; ++n) {
                const int ch = ch0 + n * 4;
                const f32x4 w0 = *(const f32x4*)(cw + ch), w1 = *(const f32x4*)(cw + DFF + ch), w2 = *(const f32x4*)(cw + 2 * DFF + ch), bb = *(const f32x4*)(cbias + ch);
#pragma unroll
                for (int ai = 0; ai < 2; ++ai) {
                    f32x4 p1 = {0.f, 0.f, 0.f, 0.f}, p2 = {0.f, 0.f, 0.f, 0.f};
                    const bool has_src = (wr == 1) || (ai == 1);
                    if (has_src) {
                        const int sb = (wr == 1) ? (ai * 2 + 0) : (0 * 2 + 1);
                        const LAS float* e = ex + sb * 256 + chl + n * 4;
                        const int srow = (sb >> 1) * 128 + (sb & 1) * 64 + 62;
                        p1 = *(const LAS f32x4*)(e + 128) * RT[srow + 1];
                        p2 = *(const LAS f32x4*)(e + (fr == 0 ? 0 : 128)) * RT[srow + (fr == 0 ? 0 : 1)];
                    }
#pragma unroll
                    for (int m = 0; m < 4; ++m) {
                        const int row = pm * 256 + ai * 128 + wr * 64 + m * 16 + fr;
                        const float rs = RT[ai * 128 + wr * 64 + m * 16 + fr];
                        const f32x4 g = acc[ai][0][m][n] * rs, v = acc[ai][1][m][n] * rs;
                        f32x4 r1, r2;
#pragma unroll
                        for (int j = 0; j < 4; ++j) { r1[j] = __shfl(g[j], src1); r2[j] = __shfl(g[j], src2); }
                        const f32x4 q1 = fr >= 1 ? r1 : p1, q2 = fr >= 2 ? r2 : p2;
                        p1 = r1; p2 = r2;
                        f32x4 o;
#pragma unroll
                        for (int j = 0; j < 4; ++j) { const float cv = bb[j] + w0[j] * q2[j] + w1[j] * q1[j] + w2[j] * g[j]; o[j] = siluf_(cv) * v[j]; }
                        const bool defer = (ai == 0 && wr == 0 && m == 0 && fr < 2);
                        if (defer) {
                            *(f32x4*)(Fg + ((size_t)pm * 2 + fr) * DFF + ch) = g; *(f32x4*)(Fv + ((size_t)pm * 2 + fr) * DFF + ch) = v;
                        } else {
                            u32x2 w; w.x = cvt_pk_bf16(o[0], o[1]); w.y = cvt_pk_bf16(o[2], o[3]);
                            *(u32x2*)(hmid + (size_t)row * DFF + ch) = w;
                        }
                        if (ai == 1 && wr == 1 && m == 3 && fr >= 14) {
                            *(f32x4*)(T + ((size_t)pm * 2 + (fr - 14)) * DFF + ch) = g;
                            if ((pm & 7) == 7) *(f32x4*)(cfp + ((size_t)(pm >> 3) * 2 + (fr - 14)) * DFF + ch) = g;
                        }
                    }
                }
            }
        } else {
#pragma unroll
            for (int n = 0; n < 2; ++n) {
                const int ch = ch0 + n * 4;
                const f32x4 w0 = *(const f32x4*)(cw + ch), w1 = *(const f32x4*)(cw + DFF + ch), w2 = *(const f32x4*)(cw + 2 * DFF + ch), bb = *(const f32x4*)(cbias + ch);
#pragma unroll
                for (int m = 0; m < 4; ++m) {
                    const int b = wr * 64 + m * 16 + fr, row = NP + b;
                    const float rs = RT[b];
                    const f32x4 g = acc[0][0][m][n] * rs, v = acc[0][1][m][n] * rs;
                    const f32x4 s0 = *(const f32x4*)(st + ((size_t)b * 2 + 0) * DFF + ch), s1 = *(const f32x4*)(st + ((size_t)b * 2 + 1) * DFF + ch);
                    f32x4 o;
#pragma unroll
                    for (int j = 0; j < 4; ++j) { const float cv = bb[j] + w0[j] * s0[j] + w1[j] * s1[j] + w2[j] * g[j]; o[j] = siluf_(cv) * v[j]; }
                    u32x2 w; w.x = cvt_pk_bf16(o[0], o[1]); w.y = cvt_pk_bf16(o[2], o[3]);
                    *(u32x2*)(hmid + (size_t)row * DFF + ch) = w;
                    *(f32x4*)(cfs + ((size_t)b * 2 + 0) * DFF + ch) = s1; *(f32x4*)(cfs + ((size_t)b * 2 + 1) * DFF + ch) = g;
                }
            }
        }
    }
};

DEV void mma16(f32x4& acc, const bf16_t* A, int lda, const bf16_t* Bt, int ldb, int K, int fr, int fq) {
    const bf16_t* a = A + fr * lda + fq * 8; const bf16_t* b = Bt + fr * ldb + fq * 8;
#pragma unroll
    for (int k = 0; k < K; k += 32) {
        const bf16x8 av = *(const bf16x8*)(a + k), bv = *(const bf16x8*)(b + k);
        acc = __builtin_amdgcn_mfma_f32_16x16x32_bf16(av, bv, acc, 0, 0, 0);
    }
}

template <int K>
DEV void sample_gemm_res(const bf16_t* __restrict__ A, const bf16_t* __restrict__ Bt, const float* __restrict__ res, float* out, bf16_t* outb, float* ssq, float* red) {
    constexpr int KQ = K / 4, UN = KQ / 64;
    const int wid = __builtin_amdgcn_readfirstlane(threadIdx.x >> 6), lane = threadIdx.x & 63, fr = lane & 15, fq = lane >> 4;
    for (int job0 = blockIdx.x * 2; job0 < 512; job0 += gridDim.x * 2) {
        const int job = job0 + (wid >> 2), kq = wid & 3, rt = job & 7, ct = job >> 3;
        const bf16_t* a = A + (size_t)(rt * 16 + fr) * K + kq * KQ + fq * 8; const bf16_t* b = Bt + (size_t)(ct * 16 + fr) * K + kq * KQ + fq * 8;
        f32x4 acc = {0.f, 0.f, 0.f, 0.f};
#pragma unroll
        for (int h = 0; h < 2; ++h) {
            bf16x8 av[UN], bv[UN];
#pragma unroll
            for (int i = 0; i < UN; ++i) { av[i] = *(const bf16x8*)(a + (h * UN + i) * 32); bv[i] = *(const bf16x8*)(b + (h * UN + i) * 32); }
#pragma unroll
            for (int i = 0; i < UN; ++i) acc = __builtin_amdgcn_mfma_f32_16x16x32_bf16(av[i], bv[i], acc, 0, 0, 0);
        }
        __syncthreads();
        *(f32x4*)(red + (wid * 64 + lane) * 4) = acc;
        __syncthreads();
        if (kq == 0) {
            const f32x4 t = acc + *(const f32x4*)(red + ((wid + 1) * 64 + lane) * 4) + *(const f32x4*)(red + ((wid + 2) * 64 + lane) * 4) + *(const f32x4*)(red + ((wid + 3) * 64 + lane) * 4);
#pragma unroll
            for (int j = 0; j < 4; ++j) {
                const int r = rt * 16 + fq * 4 + j, c = ct * 16 + fr;
                const float v = res[(size_t)r * DM + c] + t[j];
                out[(size_t)r * DM + c] = v;
                if (outb) outb[(size_t)r * DM + c] = f2bf(v);
                float ss = v * v; ss += __shfl_xor(ss, 1); ss += __shfl_xor(ss, 2); ss += __shfl_xor(ss, 4); ss += __shfl_xor(ss, 8);
                if (fr == 0) atomicAdd(ssq + r, ss);
            }
        }
    }
}

DEV void transpose_weight(const float* __restrict__ src, bf16_t* __restrict__ dst, int K, int N, int Npad, int mode, const float* __restrict__ kscale, float* tile, int item) {
    constexpr int TS = 260;
    const int ntn = Npad / 256, kt = item / ntn, nt = item % ntn, k0 = kt * 64, n0 = nt * 256, tid = threadIdx.x;
    __syncthreads();
    f32x4 v[8];
#pragma unroll
    for (int i = 0; i < 8; ++i) {
        const int e = tid + i * 512, kk = e >> 6, n4 = (e & 63) * 4;
        int sc = n0 + n4;
        if (mode == 1) sc = n4 < 128 ? nt * 128 + n4 : DFF + nt * 128 + (n4 - 128);
        v[i] = (sc < N) ? *(const f32x4*)(src + (size_t)(k0 + kk) * N + sc) : (f32x4){0.f, 0.f, 0.f, 0.f};
        if (kscale) v[i] = v[i] * kscale[k0 + kk];
    }
#pragma unroll
    for (int i = 0; i < 8; ++i) { const int e = tid + i * 512, kk = e >> 6, n4 = (e & 63) * 4; *(f32x4*)(tile + kk * TS + n4) = v[i]; }
    __syncthreads();
#pragma unroll
    for (int i = 0; i < 4; ++i) {
        const int e = tid + i * 512, nn = e & 255, k8 = (e >> 8) * 8;
        u32x4 w;
        w.x = cvt_pk_bf16(tile[(k8 + 0) * TS + nn], tile[(k8 + 1) * TS + nn]); w.y = cvt_pk_bf16(tile[(k8 + 2) * TS + nn], tile[(k8 + 3) * TS + nn]);
        w.z = cvt_pk_bf16(tile[(k8 + 4) * TS + nn], tile[(k8 + 5) * TS + nn]); w.w = cvt_pk_bf16(tile[(k8 + 6) * TS + nn], tile[(k8 + 7) * TS + nn]);
        *(u32x4*)(dst + (size_t)(n0 + nn) * K + k0 + k8) = w;
    }
}

DEV void phase_prep(const Params& p, unsigned char* smem) {
    const int tid = threadIdx.x, gtid = blockIdx.x * 512 + tid, gsz = gridDim.x * 512;
    float* ssqy = (float*)(p.ws + W_SSQY);
    for (int i = gtid; i < (int)((W_LBV - W_SSQY) / 4); i += gsz) ssqy[i] = 0.f;
    float* lbv = (float*)(p.ws + W_LBV);
    for (int i = gtid; i < 1024; i += gsz) lbv[i] = sigmoidf_(p.hgrn_lb[i] - p.hgrn_lb[1024 + i]);
    bf16_t* wb_in = (bf16_t*)((unsigned char*)p.out + O_HS * 4 + (size_t)MT * 1024 * 2);
    float* tile = (float*)smem;
    const int n_in = 16 * (DINP / 256), n_out = 32 * 4, n_up = 16 * 22, n_down = 44 * 4;
    for (int it = blockIdx.x; it < n_in + n_out + n_up + n_down; it += gridDim.x) {
        if (it < n_in) transpose_weight(p.w_in, wb_in, 1024, DIN, DINP, 0, nullptr, tile, it);
        else if (it < n_in + n_out) transpose_weight(p.w_out, (bf16_t*)(p.ws + W_OUT), 2048, 1024, 1024, 0, nullptr, tile, it - n_in);
        else if (it < n_in + n_out + n_up) transpose_weight(p.w_up, (bf16_t*)(p.ws + W_UP), 1024, 5632, 5632, 1, p.norm2_w, tile, it - n_in - n_out);
        else transpose_weight(p.w_down, (bf16_t*)(p.ws + W_DOWN), 2816, 1024, 1024, 0, nullptr, tile, it - n_in - n_out - n_up);
    }
    bf16_t* h = (bf16_t*)((unsigned char*)p.out + O_HS * 4);
    const int wid = tid >> 6, lane = tid & 63;
    for (int row = blockIdx.x * 8 + wid; row < MT; row += gridDim.x * 8) {
        if (row >= MV) {
#pragma unroll
            for (int i = 0; i < 4; ++i) *(u32x2*)(h + (size_t)row * DM + i * 256 + lane * 4) = (u32x2){0u, 0u};
            continue;
        }
        const float* xr = row < NP ? p.x_prompt + (size_t)row * DM : p.x_sample + (size_t)(row - NP) * DM;
        f32x4 v[4]; float ss = 0.f;
#pragma unroll
        for (int i = 0; i < 4; ++i) { v[i] = *(const f32x4*)(xr + i * 256 + lane * 4); ss += v[i][0] * v[i][0] + v[i][1] * v[i][1] + v[i][2] * v[i][2] + v[i][3] * v[i][3]; }
#pragma unroll
        for (int o = 32; o >= 1; o >>= 1) ss += __shfl_xor(ss, o);
        const float rs = frsq(ss * (1.f / 1024.f) + EPS);
#pragma unroll
        for (int i = 0; i < 4; ++i) { const f32x4 w = *(const f32x4*)(p.norm1_w + i * 256 + lane * 4);
            u32x2 o; o.x = cvt_pk_bf16(v[i][0] * rs * w[0], v[i][1] * rs * w[1]); o.y = cvt_pk_bf16(v[i][2] * rs * w[2], v[i][3] * rs * w[3]);
            *(u32x2*)(h + (size_t)row * DM + i * 256 + lane * 4) = o; }
    }
}

#define LBAR() do { asm volatile("s_waitcnt lgkmcnt(0)" ::: "memory"); __builtin_amdgcn_s_barrier(); asm volatile("" ::: "memory"); } while (0)

DEV void phase_conv(const Params& p) {
    const bf16_t* proj = (const bf16_t*)(p.ws + W_PROJ);
    bf16_t* xc = (bf16_t*)(p.ws + W_XC);
    const int gtid = blockIdx.x * 512 + threadIdx.x, gsz = gridDim.x * 512;
    for (int it = gtid; it < 1024 * 192; it += gsz) {
        const int cg = it % 192, rb = it / 192, c0 = cg * 8, r0 = rb * 16;
        float w[4][8], bb[8], h0[8], h1[8], h2[8];
#pragma unroll
        for (int tap = 0; tap < 4; ++tap) { const f32x4 a = *(const f32x4*)(p.ssm_conv_w + tap * 1536 + c0), c = *(const f32x4*)(p.ssm_conv_w + tap * 1536 + c0 + 4);
#pragma unroll
            for (int j = 0; j < 4; ++j) { w[tap][j] = a[j]; w[tap][4 + j] = c[j]; } }
        { const f32x4 a = *(const f32x4*)(p.ssm_conv_b + c0), c = *(const f32x4*)(p.ssm_conv_b + c0 + 4);
#pragma unroll
          for (int j = 0; j < 4; ++j) { bb[j] = a[j]; bb[4 + j] = c[j]; } }
        const bool first = (r0 & (SEQ - 1)) == 0;
        const bf16_t* src = proj + (size_t)r0 * LDP + 3072 + c0;
        bf16x8 p0 = {0, 0, 0, 0, 0, 0, 0, 0}, p1 = p0, p2 = p0;
        if (!first) { p0 = *(const bf16x8*)(src - 3 * LDP); p1 = *(const bf16x8*)(src - 2 * LDP); p2 = *(const bf16x8*)(src - LDP); }
#pragma unroll
        for (int j = 0; j < 8; ++j) { h0[j] = bf2f((bf16_t)p0[j]); h1[j] = bf2f((bf16_t)p1[j]); h2[j] = bf2f((bf16_t)p2[j]); }
#pragma unroll 4
        for (int i = 0; i < 16; ++i) {
            const bf16x8 cv = *(const bf16x8*)(src + (size_t)i * LDP);
            float o[8];
#pragma unroll
            for (int j = 0; j < 8; ++j) { const float cur = bf2f((bf16_t)cv[j]); o[j] = siluf_(bb[j] + w[0][j] * h0[j] + w[1][j] * h1[j] + w[2][j] * h2[j] + w[3][j] * cur); h0[j] = h1[j]; h1[j] = h2[j]; h2[j] = cur; }
            u32x4 wv; wv.x = cvt_pk_bf16(o[0], o[1]); wv.y = cvt_pk_bf16(o[2], o[3]); wv.z = cvt_pk_bf16(o[4], o[5]); wv.w = cvt_pk_bf16(o[6], o[7]);
            *(u32x4*)(xc + (size_t)(r0 + i) * 1536 + c0) = wv;
        }
    }
    const float* dtb = (const float*)(p.ws + W_DTB); float* dtv = (float*)(p.ws + W_DTV);
    for (int i = gtid; i < NP * 16; i += gsz) { const int h = i & 15; const float dt = softplusf_(dtb[i] + p.ssm_dt_bias[h]);
        *(f32x2*)(dtv + (size_t)i * 2) = (f32x2){dt, -__expf(p.ssm_a_log[h]) * LOG2E * dt}; }
}

DEV void hgrn_prompt_item(const Params& p, int b, int hh, unsigned char* smem) {
    constexpr int LQ = 136, LS = 72;
    bf16_t* Q = (bf16_t*)smem;
    bf16_t* KT = Q + 64 * LQ;
    bf16_t* KH = KT + 64 * LQ;
    bf16_t* VT = KH + 128 * LS;
    bf16_t* PM = VT + 128 * LS;
    bf16_t* ST = PM + 64 * LS;
    bf16_t* OUT = ST + 128 * LQ;
    float* DV = (float*)(OUT + 64 * LQ);
    float* TOT = DV + 128;
    float* RS = TOT + 8 * 128;
    const int tid = threadIdx.x, wid = __builtin_amdgcn_readfirstlane(tid >> 6), lane0 = tid & 63;
    const bf16_t* proj = (const bf16_t*)(p.ws + W_PROJ);
    bf16_t* mix = (bf16_t*)p.out;
    __syncthreads();
    for (int i = tid; i < 128 * LQ / 2; i += 512) ((unsigned*)ST)[i] = 0u;
    f32x4 S[8];
#pragma unroll
    for (int i = 0; i < 8; ++i) S[i] = (f32x4){0.f, 0.f, 0.f, 0.f};
    int lane = lane0, fr = lane & 15, fq = lane >> 4;
    unsigned gq[8], qq[8]; bf16x8 va, vb; u32x4 ga[2];
#define HG_LOAD(cc) do { const size_t _r0 = (size_t)b * SEQ + (cc) * 64; \
        _Pragma("unroll") for (int i = 0; i < 8; ++i) { const bf16_t* pr = proj + (_r0 + wid * 8 + i) * LDP + hh * 128 + lane * 2; gq[i] = *(const unsigned*)(pr + 1024); qq[i] = *(const unsigned*)pr; } \
        { const bf16_t* pv = proj + (_r0 + lane) * LDP + 2048 + hh * 128 + wid * 16; va = *(const bf16x8*)pv; vb = *(const bf16x8*)(pv + 8); } \
        _Pragma("unroll") for (int i = 0; i < 2; ++i) { const int idx = tid + 512 * i; ga[i] = *(const u32x4*)(mix + (_r0 + (idx >> 4)) * LDM + hh * 128 + (idx & 15) * 8); } } while (0)
    HG_LOAD(0);
    for (int c = 0; c < 32; ++c) {
        lane = lane0; asm volatile("" : "+v"(lane));
        fr = lane & 15; fq = lane >> 4;
        const int kp = lane * 2;
        const size_t r0 = (size_t)b * SEQ + c * 64;
        float g0[8], g1[8], q0[8], q1[8], kk0[8], kk1[8];
#pragma unroll
        for (int i = 0; i < 8; ++i) {
            g0[i] = __uint_as_float(gq[i] << 16); g1[i] = __uint_as_float(gq[i] & 0xffff0000u);
            q0[i] = __uint_as_float(qq[i] << 16); q1[i] = __uint_as_float(qq[i] & 0xffff0000u);
            kk0[i] = 1.f - fexp2(g0[i]); kk1[i] = 1.f - fexp2(g1[i]);
        }
#pragma unroll
        for (int i = 1; i < 8; ++i) { g0[i] += g0[i - 1]; g1[i] += g1[i - 1]; }
        *(f32x2*)(TOT + wid * 128 + kp) = (f32x2){g0[7], g1[7]};
        {
            const int s = lane, v0 = wid * 16;
#pragma unroll
            for (int j = 0; j < 8; ++j) { VT[(v0 + j) * LS + s] = (bf16_t)va[j]; VT[(v0 + 8 + j) * LS + s] = (bf16_t)vb[j]; }
        }
        LBAR();
        if (c > 0) {
#pragma unroll
            for (int i = 0; i < 2; ++i) { const int idx = tid + 512 * i, t = idx >> 4, v8 = (idx & 15) * 8;
                *(u32x4*)(mix + (r0 - 64 + t) * LDM + hh * 128 + v8) = *(const u32x4*)(OUT + t * LQ + v8); }
        }
        {
            float pre0 = 0.f, pre1 = 0.f, tot0 = 0.f, tot1 = 0.f;
#pragma unroll
            for (int w = 0; w < 8; ++w) { const f32x2 t = *(const f32x2*)(TOT + w * 128 + kp); if (w < wid) { pre0 += t.x; pre1 += t.y; } tot0 += t.x; tot1 += t.y; }
            if (wid == 0) *(f32x2*)(DV + kp) = (f32x2){fexp2(tot0), fexp2(tot1)};
            const float dv0 = fexp2(tot0), dv1 = fexp2(tot1);
            float h0[8], h1[8];
#pragma unroll
            for (int i = 0; i < 8; ++i) {
                const int t = wid * 8 + i;
                const float b0 = g0[i] + pre0, b1 = g1[i] + pre1;
                const float e0 = fexp2(b0), e1 = fexp2(b1), n0 = fexp2(-b0), n1 = fexp2(-b1);
                *(unsigned*)(Q + t * LQ + kp) = cvt_pk_bf16(q0[i] * e0, q1[i] * e1);
                *(unsigned*)(KT + t * LQ + kp) = cvt_pk_bf16(kk0[i] * n0, kk1[i] * n1);
                h0[i] = kk0[i] * n0 * dv0; h1[i] = kk1[i] * n1 * dv1;
            }
            {
                u32x4 w0, w1;
                w0.x = cvt_pk_bf16(h0[0], h0[1]); w0.y = cvt_pk_bf16(h0[2], h0[3]); w0.z = cvt_pk_bf16(h0[4], h0[5]); w0.w = cvt_pk_bf16(h0[6], h0[7]);
                w1.x = cvt_pk_bf16(h1[0], h1[1]); w1.y = cvt_pk_bf16(h1[2], h1[3]); w1.z = cvt_pk_bf16(h1[4], h1[5]); w1.w = cvt_pk_bf16(h1[6], h1[7]);
                *(u32x4*)(KH + kp * LS + wid * 8) = w0; *(u32x4*)(KH + (kp + 1) * LS + wid * 8) = w1;
            }
        }
        LBAR();
#pragma unroll
        for (int i = 0; i < 2; ++i) { const int idx = tid + 512 * i; *(u32x4*)(OUT + (idx >> 4) * LQ + (idx & 15) * 8) = ga[i]; }
        if (c < 31) HG_LOAD(c + 1);
        {
            const int ti = wid >> 1;
#pragma unroll
            for (int x = 0; x < 2; ++x) {
                const int si = (wid & 1) * 2 + x;
                f32x4 a = {0.f, 0.f, 0.f, 0.f};
                if (si <= ti) mma16(a, Q + ti * 16 * LQ, LQ, KT + si * 16 * LQ, LQ, 128, fr, fq);
#pragma unroll
                for (int j = 0; j < 4; ++j) { const int t = ti * 16 + fq * 4 + j, s = si * 16 + fr; PM[t * LS + s] = f2bf(s <= t ? a[j] : 0.f); }
            }
        }
        f32x4 o[4];
        const int oti = wid & 3, ovb = (wid >> 2) * 4;
#pragma unroll
        for (int x = 0; x < 4; ++x) { o[x] = (f32x4){0.f, 0.f, 0.f, 0.f}; mma16(o[x], Q + oti * 16 * LQ, LQ, ST + (ovb + x) * 16 * LQ, LQ, 128, fr, fq); }
        LBAR();
        float rsum[4] = {0.f, 0.f, 0.f, 0.f};
#pragma unroll
        for (int x = 0; x < 4; ++x) { mma16(o[x], PM + oti * 16 * LS, LS, VT + (ovb + x) * 16 * LS, LS, 64, fr, fq);
#pragma unroll
            for (int j = 0; j < 4; ++j) rsum[j] += o[x][j] * o[x][j]; }
#pragma unroll
        for (int j = 0; j < 4; ++j) { float r = rsum[j]; r += __shfl_xor(r, 1); r += __shfl_xor(r, 2); r += __shfl_xor(r, 4); r += __shfl_xor(r, 8); if (fr == 0) RS[(wid >> 2) * 64 + oti * 16 + fq * 4 + j] = r; }
        {
            const f32x4 dv = *(const f32x4*)(DV + wid * 16 + fq * 4);
#pragma unroll
            for (int x = 0; x < 8; ++x) {
                S[x] = S[x] * dv;
                mma16(S[x], KH + wid * 16 * LS, LS, VT + x * 16 * LS, LS, 64, fr, fq);
                u32x2 w; w.x = cvt_pk_bf16(S[x][0], S[x][1]); w.y = cvt_pk_bf16(S[x][2], S[x][3]);
                *(u32x2*)(ST + (x * 16 + fr) * LQ + wid * 16 + fq * 4) = w;
            }
        }
        LBAR();
#pragma unroll
        for (int j = 0; j < 4; ++j) {
            const int t = oti * 16 + fq * 4 + j;
            const float rstd = frsq((RS[t] + RS[64 + t]) * (1.f / 128.f) + EPS);
#pragma unroll
            for (int x = 0; x < 4; ++x) {
                const int v = (ovb + x) * 16 + fr;
                bf16_t* op = OUT + t * LQ + v;
                *op = f2bf(o[x][j] * rstd * p.hgrn_norm_w[v] * bf2f(*op));
            }
        }
    }
#undef HG_LOAD
    LBAR();
    {
        const size_t r0 = (size_t)b * SEQ + 31 * 64;
#pragma unroll
        for (int i = 0; i < 2; ++i) { const int idx = tid + 512 * i, t = idx >> 4, v8 = (idx & 15) * 8;
            *(u32x4*)(mix + (r0 + t) * LDM + hh * 128 + v8) = *(const u32x4*)(OUT + t * LQ + v8); }
    }
    float* hp = p.out + O_HP + ((size_t)(b * 8 + hh)) * 128 * 128;
#pragma unroll
    for (int x = 0; x < 8; ++x)
#pragma unroll
        for (int j = 0; j < 4; ++j) hp[(size_t)(wid * 16 + fq * 4 + j) * 128 + x * 16 + fr] = S[x][j];
}

DEV void ssd_prompt_item(const Params& p, int b, int hh, unsigned char* smem) {
    constexpr int LN_ = 136, LS = 72;
    bf16_t* XD = (bf16_t*)smem;
    bf16_t* XE = XD + 64 * LS;
    bf16_t* XN = XE + 64 * LS;
    bf16_t* ZG = XN + 64 * LS;
    bf16_t* OUT = ZG + 64 * LS;
    bf16_t* BN = OUT + 64 * LS;
    bf16_t* BT = BN + 64 * LN_;
    bf16_t* CN = BT + 128 * LS;
    bf16_t* MM = CN + 64 * LN_;
    bf16_t* SB = MM + 64 * LS;
    float* ACS = (float*)(SB + 64 * LN_);
    const int tid = threadIdx.x, wid = __builtin_amdgcn_readfirstlane(tid >> 6), lane0 = tid & 63;
    int lane = lane0, fr = lane & 15, fq = lane >> 4;
    const int grp = hh >> 3;
    const bf16_t* proj = (const bf16_t*)(p.ws + W_PROJ);
    const bf16_t* xc = (const bf16_t*)(p.ws + W_XC);
    const float* dtv = (const float*)(p.ws + W_DTV);
    float* ssqy = (float*)(p.ws + W_SSQY);
    bf16_t* mix = (bf16_t*)p.out;
    __syncthreads();
    for (int i = tid; i < 64 * LN_ / 2; i += 512) ((unsigned*)SB)[i] = 0u;
    f32x4 S[4];
#pragma unroll
    for (int i = 0; i < 4; ++i) S[i] = (f32x4){0.f, 0.f, 0.f, 0.f};
    const float Dh = p.ssm_d[hh];
    bf16x8 xr, br[2], cr[2]; u32x4 zr; f32x2 dta;
#define SS_LOAD(cc) do { const size_t _r0 = (size_t)b * SEQ + (cc) * 64; \
        xr = *(const bf16x8*)(xc + (_r0 + lane) * 1536 + hh * 64 + wid * 8); \
        zr = *(const u32x4*)(mix + (_r0 + lane) * LDM + 1024 + hh * 64 + wid * 8); \
        _Pragma("unroll") for (int i = 0; i < 2; ++i) { const bf16_t* pb = xc + (_r0 + lane) * 1536 + 1024 + grp * 128 + (wid + 8 * i) * 8; \
            br[i] = *(const bf16x8*)pb; cr[i] = *(const bf16x8*)(pb + 256); } \
        dta = *(const f32x2*)(dtv + ((_r0 + lane) * 16 + hh) * 2); } while (0)
    SS_LOAD(0);
    for (int c = 0; c < 32; ++c) {
        lane = lane0; asm volatile("" : "+v"(lane));
        fr = lane & 15; fq = lane >> 4;
        const size_t r0 = (size_t)b * SEQ + c * 64;
        const float dt = dta.x;
        float acs = dta.y;
#pragma unroll
        for (int o = 1; o < 64; o <<= 1) { const float u = __shfl_up(acs, o); if (lane >= o) acs += u; }
        const float alast = __shfl(acs, 63);
        if (wid == 0) ACS[lane] = acs;
        const float decl = fexp2(alast - acs);
        {
            const int tx = lane, p8 = wid * 8;
            const float dtx = dt, dex = decl * dt;
            *(bf16x8*)(XN + tx * LS + p8) = xr; *(u32x4*)(ZG + tx * LS + p8) = zr;
#pragma unroll
            for (int j = 0; j < 8; ++j) { const float xv = bf2f((bf16_t)xr[j]); XD[(p8 + j) * LS + tx] = f2bf(xv * dtx); XE[(p8 + j) * LS + tx] = f2bf(xv * dex); }
#pragma unroll
            for (int i = 0; i < 2; ++i) { const int t = lane, n8 = (wid + 8 * i) * 8;
                *(bf16x8*)(BN + t * LN_ + n8) = br[i]; *(bf16x8*)(CN + t * LN_ + n8) = cr[i];
#pragma unroll
                for (int j = 0; j < 8; ++j) BT[(n8 + j) * LS + t] = (bf16_t)br[i][j]; }
        }
        if (c < 31) SS_LOAD(c + 1);
        LBAR();
        {
            const int ti = wid >> 1;
#pragma unroll
            for (int x = 0; x < 2; ++x) {
                const int si = (wid & 1) * 2 + x;
                f32x4 a = {0.f, 0.f, 0.f, 0.f};
                if (si <= ti) mma16(a, CN + ti * 16 * LN_, LN_, BN + si * 16 * LN_, LN_, 128, fr, fq);
                const float as = ACS[si * 16 + fr];
#pragma unroll
                for (int j = 0; j < 4; ++j) { const int tt = ti * 16 + fq * 4 + j, s = si * 16 + fr; MM[tt * LS + s] = f2bf(s <= tt ? a[j] * fexp2(ACS[tt] - as) : 0.f); }
            }
        }
        f32x4 y[2];
        const int yti = wid & 3, ypb = (wid >> 2) * 2;
#pragma unroll
        for (int x = 0; x < 2; ++x) { y[x] = (f32x4){0.f, 0.f, 0.f, 0.f}; mma16(y[x], CN + yti * 16 * LN_, LN_, SB + (ypb + x) * 16 * LN_, LN_, 128, fr, fq);
#pragma unroll
            for (int j = 0; j < 4; ++j) y[x][j] *= fexp2(ACS[yti * 16 + fq * 4 + j]); }
        LBAR();
        float rsum[4] = {0.f, 0.f, 0.f, 0.f};
#pragma unroll
        for (int x = 0; x < 2; ++x) {
            mma16(y[x], MM + yti * 16 * LS, LS, XD + (ypb + x) * 16 * LS, LS, 64, fr, fq);
            const int pp = (ypb + x) * 16 + fr;
            const float wn = p.ssm_norm_w[hh * 64 + pp];
#pragma unroll
            for (int j = 0; j < 4; ++j) {
                const int tt = yti * 16 + fq * 4 + j;
                const float yv = (y[x][j] + Dh * bf2f(XN[tt * LS + pp])) * bf2f(ZG[tt * LS + pp]);
                rsum[j] += yv * yv;
                OUT[tt * LS + pp] = f2bf(yv * wn);
            }
        }
#pragma unroll
        for (int j = 0; j < 4; ++j) { float r = rsum[j]; r += __shfl_xor(r, 1); r += __shfl_xor(r, 2); r += __shfl_xor(r, 4); r += __shfl_xor(r, 8);
            if (fr == 0) atomicAdd(ssqy + (r0 + yti * 16 + fq * 4 + j) * 2 + grp, r); }
        {
            const float dl = fexp2(alast);
            const int pt = wid & 3, nb = (wid >> 2) * 4;
#pragma unroll
            for (int x = 0; x < 4; ++x) {
                S[x] = S[x] * dl;
                mma16(S[x], XE + pt * 16 * LS, LS, BT + (nb + x) * 16 * LS, LS, 64, fr, fq);
#pragma unroll
                for (int j = 0; j < 4; ++j) SB[(pt * 16 + fq * 4 + j) * LN_ + (nb + x) * 16 + fr] = f2bf(S[x][j]);
            }
        }
        LBAR();
        { const int tx = tid >> 3, p8 = (tid & 7) * 8; *(u32x4*)(mix + (r0 + tx) * LDM + 1024 + hh * 64 + p8) = *(const u32x4*)(OUT + tx * LS + p8); }
    }
#undef SS_LOAD
    {
        float* sp = p.out + O_SP + ((size_t)(b * 16 + hh)) * 64 * 128;
        const int pt = wid & 3, nb = (wid >> 2) * 4;
#pragma unroll
        for (int x = 0; x < 4; ++x)
#pragma unroll
            for (int j = 0; j < 4; ++j) sp[(size_t)(pt * 16 + fq * 4 + j) * 128 + (nb + x) * 16 + fr] = S[x][j];
    }
    if (tid < 288) { const int j = tid / 96, cc = hh * 96 + tid % 96;
        p.out[O_CSP + ((size_t)b * 3 + j) * 1536 + cc] = bf2f(proj[((size_t)b * SEQ + 2045 + j) * LDP + 3072 + cc]); }
}

DEV void hgrn_sample_item(const Params& p, int b, int hh, unsigned char* smem) {
    float* qv = (float*)smem; float* fv = qv + 128; float* kv = fv + 128; float* vv = kv + 128; float* red = vv + 128; float* sc = red + 16 * 128;
    const int tid = threadIdx.x;
    const size_t row = NP + b;
    const bf16_t* pr = (const bf16_t*)(p.ws + W_PROJ) + row * LDP + hh * 128;
    bf16_t* mix = (bf16_t*)p.out + row * LDM + hh * 128;
    __syncthreads();
    if (tid < 128) { const float f = fexp2(bf2f(pr[1024 + tid])); qv[tid] = bf2f(pr[tid]); fv[tid] = f; kv[tid] = 1.f - f; vv[tid] = bf2f(pr[2048 + tid]); }
    __syncthreads();
    const int v4 = tid & 31, kq = tid >> 5;
    const float* Sin = p.st_hgrn + ((size_t)(b * 8 + hh)) * 16384; float* Sout = p.out + O_HS + ((size_t)(b * 8 + hh)) * 16384;
    const f32x4 vx = *(const f32x4*)(vv + v4 * 4);
    f32x4 acc = {0.f, 0.f, 0.f, 0.f};
#pragma unroll
    for (int i = 0; i < 8; ++i) { const int k = kq * 8 + i; const f32x4 s = *(const f32x4*)(Sin + k * 128 + v4 * 4); const f32x4 sn = s * fv[k] + vx * kv[k];
        *(f32x4*)(Sout + k * 128 + v4 * 4) = sn; acc += sn * qv[k]; }
    *(f32x4*)(red + kq * 128 + v4 * 4) = acc;
    __syncthreads();
    float o = 0.f;
    if (tid < 128) {
#pragma unroll
        for (int i = 0; i < 16; ++i) o += red[i * 128 + tid];
        float ss = o * o;
#pragma unroll
        for (int x = 32; x >= 1; x >>= 1) ss += __shfl_xor(ss, x);
        if ((tid & 63) == 0) sc[tid >> 6] = ss;
    }
    __syncthreads();
    if (tid < 128) { const float rstd = frsq((sc[0] + sc[1]) * (1.f / 128.f) + EPS); mix[tid] = f2bf(o * rstd * p.hgrn_norm_w[tid] * bf2f(mix[tid])); }
}

DEV void ssd_sample_item(const Params& p, int b, int hh, unsigned char* smem) {
    float* xs = (float*)smem; float* Bv = xs + 64; float* Cv = Bv + 128; float* yv = Cv + 128;
    const int tid = threadIdx.x, grp = hh >> 3;
    const size_t row = NP + b;
    const bf16_t* pr = (const bf16_t*)(p.ws + W_PROJ) + row * LDP + 3072;
    const float* st = p.st_cs + (size_t)b * 3 * 1536;
    bf16_t* mix = (bf16_t*)p.out + row * LDM + 1024 + hh * 64;
    __syncthreads();
    if (tid < 320) {
        const int cc = tid < 64 ? hh * 64 + tid : (tid < 192 ? 1024 + grp * 128 + (tid - 64) : 1280 + grp * 128 + (tid - 192));
        float a = p.ssm_conv_b[cc] + p.ssm_conv_w[cc] * st[cc] + p.ssm_conv_w[1536 + cc] * st[1536 + cc] + p.ssm_conv_w[3072 + cc] * st[3072 + cc] + p.ssm_conv_w[4608 + cc] * bf2f(pr[cc]);
        a = siluf_(a);
        if (tid < 64) xs[tid] = a; else if (tid < 192) Bv[tid - 64] = a; else Cv[tid - 192] = a;
    }
    if (tid >= 384 && tid < 480) { const int cc = hh * 96 + (tid - 384);
        float* o = p.out + O_CSS + (size_t)b * 3 * 1536; o[cc] = st[1536 + cc]; o[1536 + cc] = st[3072 + cc]; o[3072 + cc] = bf2f(pr[cc]); }
    __syncthreads();
    const float dt = softplusf_(((const float*)(p.ws + W_DTB))[row * 16 + hh] + p.ssm_dt_bias[hh]);
    const float dA = __expf(-__expf(p.ssm_a_log[hh]) * dt), Dh = p.ssm_d[hh];
    const int n4 = tid & 31, pq = tid >> 5;
    const float* Sin = p.st_ssm + ((size_t)(b * 16 + hh)) * 8192; float* Sout = p.out + O_SS + ((size_t)(b * 16 + hh)) * 8192;
    const f32x4 Bx = *(const f32x4*)(Bv + n4 * 4), Cx = *(const f32x4*)(Cv + n4 * 4);
#pragma unroll
    for (int i = 0; i < 4; ++i) {
        const int pp = pq * 4 + i; const float xd = xs[pp] * dt;
        const f32x4 s = *(const f32x4*)(Sin + pp * 128 + n4 * 4); const f32x4 sn = s * dA + Bx * xd;
        *(f32x4*)(Sout + pp * 128 + n4 * 4) = sn;
        float part = sn[0] * Cx[0] + sn[1] * Cx[1] + sn[2] * Cx[2] + sn[3] * Cx[3];
#pragma unroll
        for (int x = 16; x >= 1; x >>= 1) part += __shfl_xor(part, x);
        if (n4 == 0) yv[pp] = part + Dh * xs[pp];
    }
    __syncthreads();
    if (tid < 64) {
        const float y = yv[tid] * bf2f(mix[tid]);
        float ss = y * y;
#pragma unroll
        for (int x = 32; x >= 1; x >>= 1) ss += __shfl_xor(ss, x);
        if (tid == 0) atomicAdd((float*)(p.ws + W_SSQY) + row * 2 + grp, ss);
        mix[tid] = f2bf(y * p.ssm_norm_w[hh * 64 + tid]);
    }
}

DEV void phase_scan(const Params& p, unsigned char* smem) {
    for (int it = blockIdx.x; it < 192; it += gridDim.x) {
        if (it < 64) hgrn_prompt_item(p, it >> 3, it & 7, smem);
        else ssd_prompt_item(p, (it - 64) >> 4, (it - 64) & 15, smem);
    }
    unsigned* ctr = (unsigned*)(p.ws + W_CTR);
    LAS unsigned* slot = (LAS unsigned*)(smem + LDS_BYTES - 16);
    for (;;) {
        __syncthreads();
        if (threadIdx.x == 0) *slot = atomicAdd(ctr, 1u);
        __syncthreads();
        const unsigned j = *slot;
        if (j >= 3072u) break;
        if (j < 1024u) hgrn_sample_item(p, j >> 3, j & 7, smem);
        else ssd_sample_item(p, (j - 1024u) >> 4, (j - 1024u) & 15, smem);
    }
}

DEV void phase_yscale(const Params& p) {
    bf16_t* mix = (bf16_t*)p.out; const float* ssqy = (const float*)(p.ws + W_SSQY);
    const int gsz = gridDim.x * 512;
    for (int i0 = blockIdx.x * 512 + threadIdx.x; i0 < MV * 128; i0 += gsz * 4) {
        u32x4 w[4]; float rs[4];
#pragma unroll
        for (int u = 0; u < 4; ++u) { const int i = i0 + u * gsz; if (i < MV * 128) { const int row = i >> 7, c8 = i & 127;
            w[u] = *(const u32x4*)(mix + (size_t)row * LDM + 1024 + c8 * 8); rs[u] = ssqy[row * 2 + (c8 >> 6)]; } }
#pragma unroll
        for (int u = 0; u < 4; ++u) { const int i = i0 + u * gsz; if (i < MV * 128) { const int row = i >> 7, c8 = i & 127;
            const float r = frsq(rs[u] * (1.f / 512.f) + EPS);
            unsigned* ww = (unsigned*)&w[u];
#pragma unroll
            for (int j = 0; j < 4; ++j) ww[j] = cvt_pk_bf16(__uint_as_float(ww[j] << 16) * r, __uint_as_float(ww[j] & 0xffff0000u) * r);
            *(u32x4*)(mix + (size_t)row * LDM + 1024 + c8 * 8) = w[u]; } }
    }
}

DEV void fix_hmid_rows(const Params& p, int pm) {
    const float* T = (const float*)(p.ws + W_T); const float* Fg = (const float*)(p.ws + W_FG); const float* Fv = (const float*)(p.ws + W_FV);
    bf16_t* hmid = (bf16_t*)(p.ws + W_HMID);
    for (int ch = threadIdx.x; ch < DFF; ch += 512) {
        const bool first = (pm & 7) == 0;
        const float gm2 = first ? 0.f : T[((size_t)(pm - 1) * 2 + 0) * DFF + ch], gm1 = first ? 0.f : T[((size_t)(pm - 1) * 2 + 1) * DFF + ch];
        const float G0 = Fg[((size_t)pm * 2 + 0) * DFF + ch], G1 = Fg[((size_t)pm * 2 + 1) * DFF + ch];
        const float v0 = Fv[((size_t)pm * 2 + 0) * DFF + ch], v1 = Fv[((size_t)pm * 2 + 1) * DFF + ch];
        const float w0 = p.ffn_conv_w[ch], w1 = p.ffn_conv_w[DFF + ch], w2 = p.ffn_conv_w[2 * DFF + ch], bb = p.ffn_conv_b[ch];
        hmid[(size_t)(pm * 256) * DFF + ch] = f2bf(siluf_(bb + w0 * gm2 + w1 * gm1 + w2 * G0) * v0);
        hmid[(size_t)(pm * 256 + 1) * DFF + ch] = f2bf(siluf_(bb + w0 * gm1 + w1 * G0 + w2 * G1) * v1);
    }
}

DEV void phase_final(const Params& p) {
    const float* ssq3 = (const float*)(p.ws + W_SSQ3);
    const int wid = threadIdx.x >> 6, lane = threadIdx.x & 63, wstride = gridDim.x * 8;
    f32x4 w[4];
#pragma unroll
    for (int i = 0; i < 4; ++i) w[i] = *(const f32x4*)(p.final_norm_w + i * 256 + lane * 4);
    for (int row0 = blockIdx.x * 8 + wid; row0 < MV; row0 += wstride * 4) {
        f32x4 v[4][4]; float rs[4];
#pragma unroll
        for (int u = 0; u < 4; ++u) { const int row = row0 + u * wstride; if (row < MV) { rs[u] = ssq3[row];
#pragma unroll
            for (int i = 0; i < 4; ++i) v[u][i] = *(const f32x4*)(p.out + (size_t)row * DM + i * 256 + lane * 4); } }
#pragma unroll
        for (int u = 0; u < 4; ++u) { const int row = row0 + u * wstride; if (row < MV) { const float r = frsq(rs[u] * (1.f / 1024.f) + EPS);
#pragma unroll
            for (int i = 0; i < 4; ++i) *(f32x4*)(p.out + (size_t)row * DM + i * 256 + lane * 4) = v[u][i] * w[i] * r; } }
    }
}

__global__ void __launch_bounds__(512, 2) hymba_fwd(Params p) {
    extern __shared__ __attribute__((aligned(16))) unsigned char smem[];
    cg::grid_group grid = cg::this_grid();
    LAS unsigned char* lds = (LAS unsigned char*)smem;
    bf16_t* h = (bf16_t*)((unsigned char*)p.out + O_HS * 4);
    bf16_t* wb_in = h + (size_t)MT * 1024;
    bf16_t* mix = (bf16_t*)p.out;
#define PHASE_BEGIN(k) if (p.phase_lo <= (k) && (k) < p.phase_hi) { if ((k) != p.phase_lo) grid.sync();
#define PHASE_END }
    PHASE_BEGIN(0) phase_prep(p, smem); PHASE_END
    PHASE_BEGIN(1)
        pg8::StaticOrder S; S.init(MT, DINP, gridDim.x, blockIdx.x);
        EpiIn E{(bf16_t*)(p.ws + W_PROJ), mix, (float*)(p.ws + W_DTB), (const float*)(p.ws + W_LBV)};
        pg8::gemm_phase(lds, pg8::Gemm{h, wb_in, MT, DINP, 1024}, S, E);
    PHASE_END
    PHASE_BEGIN(2) phase_conv(p); PHASE_END
    PHASE_BEGIN(3) phase_scan(p, smem); PHASE_END
    PHASE_BEGIN(4) phase_yscale(p); PHASE_END
    PHASE_BEGIN(5)
        pg8::StaticOrder S; S.init(NP, 1024, gridDim.x, blockIdx.x);
        EpiRes E{p.x_prompt, p.x_sample, (float*)(p.ws + W_X1), (bf16_t*)(p.ws + W_X1B), (float*)(p.ws + W_SSQ2)};
        pg8::gemm_phase(lds, pg8::Gemm{mix, (const bf16_t*)(p.ws + W_OUT), NP, 1024, 2048}, S, E);
        sample_gemm_res<2048>(mix + (size_t)NP * LDM, (const bf16_t*)(p.ws + W_OUT), p.x_sample, (float*)(p.ws + W_X1) + (size_t)NP * DM,
                        (bf16_t*)(p.ws + W_X1B) + (size_t)NP * DM, (float*)(p.ws + W_SSQ2) + NP, (float*)smem);
    PHASE_END
    PHASE_BEGIN(6)
        pg8::StaticOrder S; S.init(MT, 5632, gridDim.x, blockIdx.x);
        EpiUp E{(bf16_t*)(p.ws + W_HMID), (const float*)(p.ws + W_SSQ2), p.ffn_conv_w, p.ffn_conv_b, (float*)(p.ws + W_T), (float*)(p.ws + W_FG), (float*)(p.ws + W_FV),
                p.st_cf, p.out + O_CFP, p.out + O_CFS, (LAS float*)(lds + 131072)};
        pg8::gemm_phase(lds, pg8::Gemm{(const bf16_t*)(p.ws + W_X1B), (const bf16_t*)(p.ws + W_UP), MT, 5632, 1024}, S, E);
    PHASE_END
    PHASE_BEGIN(7) for (int pm = blockIdx.x; pm < 64; pm += gridDim.x) fix_hmid_rows(p, pm); PHASE_END
    PHASE_BEGIN(8)
        pg8::StaticOrder S; S.init(NP, 1024, gridDim.x, blockIdx.x);
        const float* x1 = (const float*)(p.ws + W_X1);
        EpiRes E{x1, x1 + (size_t)NP * DM, p.out, nullptr, (float*)(p.ws + W_SSQ3)};
        pg8::gemm_phase(lds, pg8::Gemm{(const bf16_t*)(p.ws + W_HMID), (const bf16_t*)(p.ws + W_DOWN), NP, 1024, DFF}, S, E);
        sample_gemm_res<DFF>((const bf16_t*)(p.ws + W_HMID) + (size_t)NP * DFF, (const bf16_t*)(p.ws + W_DOWN), x1 + (size_t)NP * DM, p.out + (size_t)NP * DM,
                        nullptr, (float*)(p.ws + W_SSQ3) + NP, (float*)smem);
    PHASE_END
    PHASE_BEGIN(9) phase_final(p); PHASE_END
}

extern "C" void kernel_launch(void* const* d_in, const int* in_sizes, int n_in, void* d_out, int out_size, void* d_ws, size_t ws_size, hipStream_t stream) {
    static int grid_blocks = 0;
    if (!grid_blocks) {
        int dev = 0, cus = 0, per_cu = 0;
        hipGetDevice(&dev);
        hipDeviceGetAttribute(&cus, hipDeviceAttributeMultiprocessorCount, dev);
        hipFuncSetAttribute((const void*)hymba_fwd, hipFuncAttributeMaxDynamicSharedMemorySize, LDS_BYTES);
        hipOccupancyMaxActiveBlocksPerMultiprocessor(&per_cu, hymba_fwd, 512, LDS_BYTES);
        if (per_cu < 1) per_cu = 1;
        grid_blocks = cus * per_cu;
        if (grid_blocks > 256) grid_blocks = 256;
        if (ws_size < W_END) fprintf(stderr, "workspace too small: %zu < %zu\n", ws_size, (size_t)W_END);
    }
    Params p{};
    const float** f = (const float**)&p;
    for (int i = 0; i < 23; ++i) f[i] = (const float*)d_in[i];
    p.out = (float*)d_out; p.ws = (unsigned char*)d_ws;
#ifndef PROBE_HI
#define PROBE_HI 10
#endif
#ifndef MK_SPLIT
#define MK_SPLIT 0
#endif
#if MK_SPLIT
    for (int k = 0; k < PROBE_HI; ++k) {
        p.phase_lo = k; p.phase_hi = k + 1;
        hipLaunchKernelGGL(hymba_fwd, dim3(grid_blocks), dim3(512), LDS_BYTES, stream, p);
    }
    if (PROBE_HI == 2) {
        hipMemcpyAsync((float*)d_out + O_SS, (unsigned char*)d_ws + W_PROJ, (size_t)64 << 20, hipMemcpyDeviceToDevice, stream);
        hipMemcpyAsync((float*)d_out + O_SP, (unsigned char*)d_ws + W_DTB, (size_t)1 << 20, hipMemcpyDeviceToDevice, stream);
    }
#else
    p.phase_lo = 0; p.phase_hi = 10;
    void* args[] = {&p};
    hipError_t e = hipLaunchCooperativeKernel((const void*)hymba_fwd, dim3(grid_blocks), dim3(512), args, LDS_BYTES, stream);
    if (e != hipSuccess) fprintf(stderr, "cooperative launch failed: %s (grid %d)\n", hipGetErrorString(e), grid_blocks);
#endif
}
```

```cpp
#include <hip/hip_runtime.h>
#include <hip/hip_cooperative_groups.h>
#include <cstdio>
namespace cg = cooperative_groups;

#define DEV __device__ __forceinline__
#define PROBE_NOMIX 0
#define LAS __attribute__((address_space(3)))
typedef unsigned short bf16_t;
typedef short bf16x8 __attribute__((ext_vector_type(8)));
typedef float f32x4 __attribute__((ext_vector_type(4)));
typedef float f32x2 __attribute__((ext_vector_type(2)));
typedef unsigned u32x2 __attribute__((ext_vector_type(2)));
typedef unsigned u32x4 __attribute__((ext_vector_type(4)));

constexpr int NP = 16384, NSMP = 128, MV = NP + NSMP, MT = 16640;
constexpr int DM = 1024, DIN = 6672, DINP = 6912, DFF = 2816, LDP = 4608, LDM = 2048;
constexpr int SEQ = 2048, NB = 8;
constexpr float EPS = 1e-6f, LOG2E = 1.4426950408889634f, LN2 = 0.6931471805599453f;
constexpr int LDS_BYTES = 131072 + 8192;

constexpr size_t O_YP = 0, O_YS = 16777216, O_HP = 16908288, O_HS = 17956864, O_SP = 34734080, O_SS = 35782656,
                 O_CSP = 52559872, O_CSS = 52596736, O_CFP = 53186560, O_CFS = 53231616;
constexpr size_t W_OUT = 0, W_UP = W_OUT + (size_t)1024 * 2048 * 2, W_DOWN = W_UP + (size_t)5632 * 1024 * 2,
                 W_SSQY = W_DOWN + (size_t)1024 * 2816 * 2, W_SSQ2 = W_SSQY + (size_t)MT * 2 * 4, W_SSQ3 = W_SSQ2 + (size_t)MT * 4,
                 W_CTR = W_SSQ3 + (size_t)MT * 4, W_LBV = W_CTR + 256, W_DTB = W_LBV + 4096, W_T = W_DTB + (size_t)MT * 16 * 4,
                 W_FG = W_T + (size_t)65 * 2 * DFF * 4, W_FV = W_FG + (size_t)65 * 2 * DFF * 4, W_BIG = ((W_FV + (size_t)65 * 2 * DFF * 4 + 4095) / 4096) * 4096,
                 W_PROJ = W_BIG, W_X1 = W_BIG, W_X1B = W_X1 + (size_t)MT * 1024 * 4, W_HMID = W_X1B + (size_t)MT * 1024 * 2,
                 W_END = W_HMID + (size_t)MT * DFF * 2, W_XC = W_PROJ + (size_t)MT * LDP * 2, W_DTV = W_XC + (size_t)NP * 1536 * 2, W_END2 = W_DTV + (size_t)NP * 16 * 2 * 4;
static_assert(W_END2 <= (size_t)256 * 1024 * 1024 && W_END <= (size_t)256 * 1024 * 1024, "workspace budget");
static_assert(W_PROJ + (size_t)MT * LDP * 2 <= W_END, "layout");

struct Params {
    const float *x_prompt, *x_sample, *st_hgrn, *st_ssm, *st_cs, *st_cf, *norm1_w, *w_in, *hgrn_lb, *hgrn_norm_w, *ssm_conv_w, *ssm_conv_b,
        *ssm_dt_bias, *ssm_a_log, *ssm_d, *ssm_norm_w, *w_out, *norm2_w, *w_up, *ffn_conv_w, *ffn_conv_b, *w_down, *final_norm_w;
    float* out; unsigned char* ws;
    int phase_lo, phase_hi;
};

DEV float bf2f(bf16_t v) { return __uint_as_float(((unsigned)v) << 16); }
typedef __bf16 bf16x2_t __attribute__((ext_vector_type(2)));
DEV unsigned cvt_pk_bf16(float lo, float hi) { f32x2 f = {lo, hi}; bf16x2_t v = __builtin_convertvector(f, bf16x2_t); return __builtin_bit_cast(unsigned, v); }
DEV bf16_t f2bf(float f) { return (bf16_t)(cvt_pk_bf16(f, 0.f) & 0xffffu); }
DEV float fexp2(float x) { return __builtin_amdgcn_exp2f(x); }
DEV float flog2(float x) { return __builtin_amdgcn_logf(x); }
DEV float frcp(float x) { return __builtin_amdgcn_rcpf(x); }
DEV float frsq(float x) { return __builtin_amdgcn_rsqf(x); }
DEV float sigmoidf_(float x) { return frcp(1.f + fexp2(-x * LOG2E)); }
DEV float siluf_(float x) { return x * sigmoidf_(x); }
DEV float softplusf_(float x) { return x > 20.f ? x : LN2 * flog2(1.f + fexp2(x * LOG2E)); }

namespace pg8 {
constexpr int BM = 256, BK = 64, HALF = 128, HTB = HALF * BK * 2, STAGE_BYTES = 8 * HTB, NXCD = 8, WGM = 8;
DEV int lds_byte(int r, int c) { const int st = (r >> 4) * 2 + (c >> 5), rr = r & 15, cc = c & 31, ob = rr * 64 + cc * 2; return st * 1024 + (ob ^ (((ob >> 9) & 1) << 5)); }
DEV void stage_rc(int b, int& R, int& C) { const int st = b / 1024, sb = b % 1024, swz = sb ^ (((sb >> 9) & 1) << 5); R = (st >> 1) * 16 + swz / 64; C = (st & 1) * 32 + (swz % 64) / 2; }
DEV int perm32(int rho) { const int n = rho >> 4, i = rho & 15; return 8 * (i >> 2) + 4 * n + (i & 3); }
struct Unit { int pm, pn; };
struct Gemm { const bf16_t* A; const bf16_t* Bt; int M, N, K; };
struct StaticOrder {
    int nM, nN, nwg, G, c;
    DEV void init(int M, int N, int G_, int c_) { nM = M / BM; nN = N / BM; nwg = nM * nN; G = G_; c = c_; }
    DEV bool next(int i, Unit& u) const {
        const long L = (long)i * G + c; if (L >= nwg) return false;
        int wgid = (int)L; { const int q = nwg / NXCD, r = nwg % NXCD, xcd = wgid % NXCD, off = wgid / NXCD; wgid = (xcd < r ? xcd * (q + 1) : r * (q + 1) + (xcd - r) * q) + off; }
        const int nig = WGM * nN, gid = wgid / nig, fm = gid * WGM, gsz = (nM - fm) < WGM ? (nM - fm) : WGM;
        u.pm = fm + ((wgid % nig) % gsz); u.pn = (wgid % nig) / gsz; return true;
    }
};

template <class Epi>
DEV void gemm_phase(LAS unsigned char* lds, const Gemm g, const StaticOrder& S, const Epi& E) {
    const int tid = threadIdx.x, wid = __builtin_amdgcn_readfirstlane(tid >> 6), lane = tid & 63, wr = wid >> 2, wc = wid & 3, fr = lane & 15, fq = lane >> 4;
    const int K = g.K, nt = K / BK;
    unsigned voffA[2], voffB[2];
#pragma unroll
    for (int i = 0; i < 2; ++i) { int R, C; stage_rc(tid * 16 + i * 8192, R, C); const int Rb = Epi::PERM ? ((R & ~31) + perm32(R & 31)) : R;
        voffA[i] = (unsigned)(R * K + C) * 2u; voffB[i] = (unsigned)(Rb * K + C) * 2u; }
    const size_t kstep = (size_t)(BK * 2);
    const size_t hstep = (size_t)HALF * K * 2;
    const size_t tstep = 2 * hstep;
    const unsigned ldsw = (unsigned)wid * 1024u;
    const int aoff = lds_byte(wr * 64 + fr, fq * 8), boff = lds_byte(wc * 32 + fr, fq * 8);
#define PG8_SA(b, h) (((b) * 2 + (h)) * HTB)
#define PG8_SB(b, h) ((4 + (b) * 2 + (h)) * HTB)
#define PG8_STAGE(bufoff, gbase, voff) do { _Pragma("unroll") for (int _i = 0; _i < 2; ++_i) \
        __builtin_amdgcn_global_load_lds((const unsigned*)((const char*)(gbase) + (voff)[_i]), (LAS unsigned*)(lds + (bufoff) + ldsw + _i * 8192), 16, 0, 0); } while (0)
#define PG8_LDA(dst, b, h) do { _Pragma("unroll") for (int m = 0; m < 4; ++m) _Pragma("unroll") for (int k = 0; k < 2; ++k) dst[m][k] = *(const LAS bf16x8*)(lds + PG8_SA(b, h) + aoff + m * 2048 + k * 1024); } while (0)
#define PG8_LDB(dst, b, h) do { _Pragma("unroll") for (int n = 0; n < 2; ++n) _Pragma("unroll") for (int k = 0; k < 2; ++k) dst[n][k] = *(const LAS bf16x8*)(lds + PG8_SB(b, h) + boff + n * 2048 + k * 1024); } while (0)
#define PG8_MMA(ai, bj, At, Bt) do { __builtin_amdgcn_s_setprio(1); _Pragma("unroll") for (int m = 0; m < 4; ++m) _Pragma("unroll") for (int n = 0; n < 2; ++n) _Pragma("unroll") for (int k = 0; k < 2; ++k) \
        acc[ai][bj][m][n] = __builtin_amdgcn_mfma_f32_16x16x32_bf16(Bt[n][k], At[m][k], acc[ai][bj][m][n], 0, 0, 0); __builtin_amdgcn_s_setprio(0); } while (0)
#define PG8_WAIT_V(n) asm volatile("s_waitcnt vmcnt(" #n ")" ::: "memory")
#define PG8_WAIT_L(n) asm volatile("s_waitcnt lgkmcnt(" #n ")" ::: "memory")
#define PG8_BAR __builtin_amdgcn_s_barrier()
#define PG8_SCHED __builtin_amdgcn_sched_barrier(0)
    Unit cur, nxt; int ui = 0;
    if (!S.next(0, cur)) return;
    f32x4 acc[2][2][4][2];
#pragma unroll
    for (int a = 0; a < 2; ++a)
#pragma unroll
        for (int b = 0; b < 2; ++b)
#pragma unroll
            for (int m = 0; m < 4; ++m)
#pragma unroll
                for (int n = 0; n < 2; ++n) acc[a][b][m][n] = (f32x4){0.f, 0.f, 0.f, 0.f};
    bf16x8 At[4][2], B0[2][2], B1[2][2];
    const char* cA = (const char*)g.A + (size_t)cur.pm * tstep; const char* cB = (const char*)g.Bt + (size_t)cur.pn * tstep;
    PG8_STAGE(PG8_SB(0, 0), cB, voffB); PG8_STAGE(PG8_SA(0, 0), cA, voffA); PG8_STAGE(PG8_SB(0, 1), cB + hstep, voffB); PG8_STAGE(PG8_SA(0, 1), cA + hstep, voffA);
    if (wr == 1) PG8_BAR;
    PG8_WAIT_V(4); PG8_BAR;
    PG8_STAGE(PG8_SB(1, 0), cB + kstep, voffB); PG8_STAGE(PG8_SA(1, 0), cA + kstep, voffA); PG8_STAGE(PG8_SB(1, 1), cB + hstep + kstep, voffB);
    PG8_WAIT_V(6); PG8_BAR;
    for (;;) {
        const bool has_next = S.next(ui + 1, nxt);
        const char* nA = has_next ? (const char*)g.A + (size_t)nxt.pm * tstep : cA; const char* nB = has_next ? (const char*)g.Bt + (size_t)nxt.pn * tstep : cB;
        for (int t = 0; t < nt; t += 2) {
            const bool last = (t == nt - 2);
            const char* a1 = cA + (size_t)(t + 1) * kstep;
            const char* a2 = last ? nA : cA + (size_t)(t + 2) * kstep; const char* b2 = last ? nB : cB + (size_t)(t + 2) * kstep;
            const char* a3 = a2 + kstep; const char* b3 = b2 + kstep;
            PG8_LDB(B0, 0, 0); PG8_SCHED; PG8_LDA(At, 0, 0); PG8_STAGE(PG8_SA(1, 1), a1 + hstep, voffA);
            PG8_WAIT_L(8); PG8_BAR; PG8_WAIT_L(0); PG8_MMA(0, 0, At, B0); PG8_BAR; PG8_SCHED;
            PG8_LDB(B1, 0, 1); PG8_STAGE(PG8_SB(0, 0), b2, voffB);
            PG8_BAR; PG8_WAIT_L(0); PG8_MMA(0, 1, At, B1); PG8_BAR;
            PG8_LDA(At, 0, 1); PG8_STAGE(PG8_SA(0, 0), a2, voffA);
            PG8_BAR; PG8_WAIT_L(0); PG8_MMA(1, 0, At, B0); PG8_BAR; PG8_SCHED;
            PG8_STAGE(PG8_SB(0, 1), b2 + hstep, voffB);
            PG8_WAIT_V(6); PG8_BAR; PG8_MMA(1, 1, At, B1); PG8_BAR;
            PG8_LDB(B0, 1, 0); PG8_SCHED; PG8_LDA(At, 1, 0); PG8_STAGE(PG8_SA(0, 1), a2 + hstep, voffA);
            PG8_WAIT_L(8); PG8_BAR; PG8_WAIT_L(0); PG8_MMA(0, 0, At, B0); PG8_BAR; PG8_SCHED;
            PG8_LDB(B1, 1, 1); PG8_STAGE(PG8_SB(1, 0), b3, voffB);
            PG8_BAR; PG8_WAIT_L(0); PG8_MMA(0, 1, At, B1); PG8_BAR;
            PG8_LDA(At, 1, 1); PG8_STAGE(PG8_SA(1, 0), a3, voffA);
            PG8_BAR; PG8_WAIT_L(0); PG8_MMA(1, 0, At, B0); PG8_BAR; PG8_SCHED;
            PG8_STAGE(PG8_SB(1, 1), b3 + hstep, voffB);
            PG8_WAIT_V(6); PG8_BAR; PG8_MMA(1, 1, At, B1); PG8_BAR;
            if constexpr (Epi::RESCALE) { if (t + 2 == 16 || t + 2 == 24) E.rescale(acc, cur, t + 2, wr, fr); }
        }
        E(acc, cur, wr, wc, fr, fq);
        if (!has_next) break;
#pragma unroll
        for (int a = 0; a < 2; ++a)
#pragma unroll
            for (int b = 0; b < 2; ++b)
#pragma unroll
                for (int m = 0; m < 4; ++m)
#pragma unroll
                    for (int n = 0; n < 2; ++n) acc[a][b][m][n] = (f32x4){0.f, 0.f, 0.f, 0.f};
        cur = nxt; cA = nA; cB = nB; ++ui;
    }
    PG8_WAIT_V(0);
    if (wr == 0) PG8_BAR;
    PG8_BAR;
#undef PG8_SA
#undef PG8_SB
#undef PG8_STAGE
#undef PG8_LDA
#undef PG8_LDB
#undef PG8_MMA
#undef PG8_WAIT_V
#undef PG8_WAIT_L
#undef PG8_BAR
#undef PG8_SCHED
}
}
using pg8::Unit;

struct EpiIn {
    static constexpr bool PERM = true, RESCALE = false;
    bf16_t* proj; bf16_t* mix; float* dtb; const float* lbv;
    DEV void operator()(const f32x4 (&acc)[2][2][4][2], const Unit& u, int wr, int wc, int fr, int fq) const {
        asm volatile("" : "+v"(fr), "+v"(fq));
#pragma unroll
        for (int bj = 0; bj < 2; ++bj) {
            const int cb = u.pn * 256 + bj * 128, c0 = cb + wc * 32 + fq * 8;
            int kind; bf16_t* dst; int ld;
            if (cb < 1024) { kind = 1; dst = proj + c0; ld = LDP; }
            else if (cb < 2048) { kind = 2; dst = proj + c0; ld = LDP; }
            else if (cb < 3072) { kind = 0; dst = proj + c0; ld = LDP; }
            else if (cb < 4096) { kind = 1; dst = mix + (c0 - 3072); ld = LDM; }
            else if (cb < 5120) { kind = 1; dst = mix + 1024 + (c0 - 4096); ld = LDM; }
            else if (cb < 6656) { kind = 0; dst = proj + 3072 + (c0 - 5120); ld = LDP; }
            else if (cb == 6656) { kind = 3; dst = nullptr; ld = 0; }
            else continue;
            f32x4 lb0 = {0.f, 0.f, 0.f, 0.f}, lb1 = {0.f, 0.f, 0.f, 0.f};
            if (kind == 2) { lb0 = *(const f32x4*)(lbv + c0 - 1024); lb1 = *(const f32x4*)(lbv + c0 - 1024 + 4); }
#pragma unroll
            for (int ai = 0; ai < 2; ++ai)
#pragma unroll
                for (int m = 0; m < 4; ++m) {
                    const int row = u.pm * 256 + ai * 128 + wr * 64 + m * 16 + fr;
                    if (row >= MV) continue;
                    f32x4 v0 = acc[ai][bj][m][0], v1 = acc[ai][bj][m][1];
                    if (kind == 3) { if (c0 < DIN) { float* d = dtb + (size_t)row * 16 + (c0 - 6656); *(f32x4*)d = v0; *(f32x4*)(d + 4) = v1; } continue; }
                    if (kind == 1) {
#pragma unroll
                        for (int j = 0; j < 4; ++j) { v0[j] = siluf_(v0[j]); v1[j] = siluf_(v1[j]); }
                    } else if (kind == 2) {
#pragma unroll
                        for (int j = 0; j < 4; ++j) { v0[j] = flog2(lb0[j] + (1.f - lb0[j]) * sigmoidf_(v0[j])); v1[j] = flog2(lb1[j] + (1.f - lb1[j]) * sigmoidf_(v1[j])); }
                    }
                    u32x4 w; w.x = cvt_pk_bf16(v0[0], v0[1]); w.y = cvt_pk_bf16(v0[2], v0[3]); w.z = cvt_pk_bf16(v1[0], v1[1]); w.w = cvt_pk_bf16(v1[2], v1[3]);
                    *(u32x4*)(dst + (size_t)row * ld) = w;
                }
        }
    }
};

template <bool RS_>
struct EpiRes {
    static constexpr bool PERM = false, RESCALE = RS_;
    const float* r0; const float* r1;
    float* out; bf16_t* outb; float* ssq; const float* ssqy;
    DEV void rescale(f32x4 (&acc)[2][2][4][2], const Unit& u, int t, int wr, int fr) const {
        asm volatile("" : "+v"(fr));
#pragma unroll
        for (int ai = 0; ai < 2; ++ai)
#pragma unroll
            for (int m = 0; m < 4; ++m) {
                const int row = u.pm * 256 + ai * 128 + wr * 64 + m * 16 + fr;
                const f32x2 q = *(const f32x2*)(ssqy + (size_t)row * 2);
                const float a0 = q.x * (1.f / 512.f) + EPS, a1 = q.y * (1.f / 512.f) + EPS;
                const float sc = t == 16 ? __builtin_sqrtf(a0) : frsq(a0) * __builtin_sqrtf(a1);
#pragma unroll
                for (int bj = 0; bj < 2; ++bj)
#pragma unroll
                    for (int n = 0; n < 2; ++n) acc[ai][bj][m][n] = acc[ai][bj][m][n] * sc;
            }
    }
    DEV void operator()(const f32x4 (&acc)[2][2][4][2], const Unit& u, int wr, int wc, int fr, int fq) const {
        asm volatile("" : "+v"(fr), "+v"(fq));
        const int cbase = u.pn * 256 + wc * 32 + fq * 4;
#pragma unroll
        for (int ai = 0; ai < 2; ++ai) {
            const int rowb = u.pm * 256 + ai * 128 + wr * 64 + fr;
            f32x4 res[4][2][2]; float fin[4];
#pragma unroll
            for (int m = 0; m < 4; ++m) {
                const int row = rowb + m * 16, rc = row < MV ? row : 0;
                const float* rr = rc < NP ? r0 + (size_t)rc * DM : r1 + (size_t)(rc - NP) * DM;
#pragma unroll
                for (int bj = 0; bj < 2; ++bj)
#pragma unroll
                    for (int n = 0; n < 2; ++n) res[m][bj][n] = *(const f32x4*)(rr + cbase + bj * 128 + n * 16);
                fin[m] = RS_ ? frsq(ssqy[(size_t)rc * 2 + 1] * (1.f / 512.f) + EPS) : 1.f;
            }
#pragma unroll
            for (int m = 0; m < 4; ++m) {
                const int row = rowb + m * 16;
                const bool ok = row < MV;
                float ss = 0.f;
#pragma unroll
                for (int bj = 0; bj < 2; ++bj)
#pragma unroll
                    for (int n = 0; n < 2; ++n) {
                        const int c = cbase + bj * 128 + n * 16;
                        const f32x4 v = res[m][bj][n] + (RS_ ? acc[ai][bj][m][n] * fin[m] : acc[ai][bj][m][n]);
                        if (ok) {
                            *(f32x4*)(out + (size_t)row * DM + c) = v;
                            if (outb) { u32x2 w; w.x = cvt_pk_bf16(v[0], v[1]); w.y = cvt_pk_bf16(v[2], v[3]); *(u32x2*)(outb + (size_t)row * DM + c) = w; }
                        }
                        ss += v[0] * v[0] + v[1] * v[1] + v[2] * v[2] + v[3] * v[3];
                    }
                ss += __shfl_xor(ss, 16); ss += __shfl_xor(ss, 32);
                if (ok && fq == 0) atomicAdd(ssq + row, ss);
            }
        }
    }
};

struct EpiUp {
    static constexpr bool PERM = true, RESCALE = false;
    bf16_t* hmid; const float* ssq2; const float* cw; const float* cbias; float* T; float* Fg; float* Fv; const float* st; float* cfp; float* cfs;
    LAS float* ex;
    DEV void operator()(const f32x4 (&acc)[2][2][4][2], const Unit& u, int wr, int wc, int fr, int fq) const {
        asm volatile("" : "+v"(fr), "+v"(fq));
        const int pm = u.pm, lane = fq * 16 + fr;
        const int chl = wc * 32 + fq * 8;
        const int ch0 = u.pn * 128 + chl;
        LAS float* RT = ex + 1024;
        if (wr == 0) { const int r = wc * 64 + lane, row = pm * 256 + r; RT[r] = row < MV ? frsq(ssq2[row] * (1.f / 1024.f) + EPS) : 0.f; }
#pragma unroll
        for (int ai = 0; ai < 2; ++ai) {
            if (fr >= 14) {
                LAS float* e = ex + ((ai * 2 + wr) * 2 + (fr - 14)) * 128 + chl;
                *(LAS f32x4*)e = acc[ai][0][3][0]; *(LAS f32x4*)(e + 4) = acc[ai][0][3][1];
            }
        }
        __syncthreads(); __syncthreads();
        const int src1 = (lane & 48) | ((fr - 1) & 15), src2 = (lane & 48) | ((fr - 2) & 15);
        if (pm < 64) {
#pragma unroll
            for (int n = 0; n < 2; ++n) {
                const int ch = ch0 + n * 4;
                const f32x4 w0 = *(const f32x4*)(cw + ch), w1 = *(const f32x4*)(cw + DFF + ch), w2 = *(const f32x4*)(cw + 2 * DFF + ch), bb = *(const f32x4*)(cbias + ch);
#pragma unroll
                for (int ai = 0; ai < 2; ++ai) {
                    f32x4 p1 = {0.f, 0.f, 0.f, 0.f}, p2 = {0.f, 0.f, 0.f, 0.f};
                    const bool has_src = (wr == 1) || (ai == 1);
                    if (has_src) {
                        const int sb = (wr == 1) ? (ai * 2 + 0) : (0 * 2 + 1);
                        const LAS float* e = ex + sb * 256 + chl + n * 4;
                        const int srow = (sb >> 1) * 128 + (sb & 1) * 64 + 62;
                        p1 = *(const LAS f32x4*)(e + 128) * RT[srow + 1];
                        p2 = *(const LAS f32x4*)(e + (fr == 0 ? 0 : 128)) * RT[srow + (fr == 0 ? 0 : 1)];
                    }
#pragma unroll
                    for (int m = 0; m < 4; ++m) {
                        const int row = pm * 256 + ai * 128 + wr * 64 + m * 16 + fr;
                        const float rs = RT[ai * 128 + wr * 64 + m * 16 + fr];
                        const f32x4 g = acc[ai][0][m][n] * rs, v = acc[ai][1][m][n] * rs;
                        f32x4 r1, r2;
#pragma unroll
                        for (int j = 0; j < 4; ++j) { r1[j] = __shfl(g[j], src1); r2[j] = __shfl(g[j], src2); }
                        const f32x4 q1 = fr >= 1 ? r1 : p1, q2 = fr >= 2 ? r2 : p2;
                        p1 = r1; p2 = r2;
                        f32x4 o;
#pragma unroll
                        for (int j = 0; j < 4; ++j) { const float cv = bb[j] + w0[j] * q2[j] + w1[j] * q1[j] + w2[j] * g[j]; o[j] = siluf_(cv) * v[j]; }
                        const bool defer = (ai == 0 && wr == 0 && m == 0 && fr < 2);
                        if (defer) {
                            *(f32x4*)(Fg + ((size_t)pm * 2 + fr) * DFF + ch) = g; *(f32x4*)(Fv + ((size_t)pm * 2 + fr) * DFF + ch) = v;
                        } else {
                            u32x2 w; w.x = cvt_pk_bf16(o[0], o[1]); w.y = cvt_pk_bf16(o[2], o[3]);
                            *(u32x2*)(hmid + (size_t)row * DFF + ch) = w;
                        }
                        if (ai == 1 && wr == 1 && m == 3 && fr >= 14) {
                            *(f32x4*)(T + ((size_t)pm * 2 + (fr - 14)) * DFF + ch) = g;
                            if ((pm & 7) == 7) *(f32x4*)(cfp + ((size_t)(pm >> 3) * 2 + (fr - 14)) * DFF + ch) = g;
                        }
                    }
                }
            }
        } else {
#pragma unroll
            for (int n = 0; n < 2; ++n) {
                const int ch = ch0 + n * 4;
                const f32x4 w0 = *(const f32x4*)(cw + ch), w1 = *(const f32x4*)(cw + DFF + ch), w2 = *(const f32x4*)(cw + 2 * DFF + ch), bb = *(const f32x4*)(cbias + ch);
#pragma unroll
                for (int m = 0; m < 4; ++m) {
                    const int b = wr * 64 + m * 16 + fr, row = NP + b;
                    const float rs = RT[b];
                    const f32x4 g = acc[0][0][m][n] * rs, v = acc[0][1][m][n] * rs;
                    const f32x4 s0 = *(const f32x4*)(st + ((size_t)b * 2 + 0) * DFF + ch), s1 = *(const f32x4*)(st + ((size_t)b * 2 + 1) * DFF + ch);
                    f32x4 o;
#pragma unroll
                    for (int j = 0; j < 4; ++j) { const float cv = bb[j] + w0[j] * s0[j] + w1[j] * s1[j] + w2[j] * g[j]; o[j] = siluf_(cv) * v[j]; }
                    u32x2 w; w.x = cvt_pk_bf16(o[0], o[1]); w.y = cvt_pk_bf16(o[2], o[3]);
                    *(u32x2*)(hmid + (size_t)row * DFF + ch) = w;
                    *(f32x4*)(cfs + ((size_t)b * 2 + 0) * DFF + ch) = s1; *(f32x4*)(cfs + ((size_t)b * 2 + 1) * DFF + ch) = g;
                }
            }
        }
    }
};

DEV void mma16(f32x4& acc, const bf16_t* A, int lda, const bf16_t* Bt, int ldb, int K, int fr, int fq) {
    const bf16_t* a = A + fr * lda + fq * 8; const bf16_t* b = Bt + fr * ldb + fq * 8;
#pragma unroll
    for (int k = 0; k < K; k += 32) {
        const bf16x8 av = *(const bf16x8*)(a + k), bv = *(const bf16x8*)(b + k);
        acc = __builtin_amdgcn_mfma_f32_16x16x32_bf16(av, bv, acc, 0, 0, 0);
    }
}

template <int K>
DEV void sample_gemm_res(const bf16_t* __restrict__ A, const bf16_t* __restrict__ Bt, const float* __restrict__ res, float* out, bf16_t* outb, float* ssq, float* red, const float* ssqy) {
    constexpr int KQ = K / 4, UN = KQ / 64;
    const int wid = __builtin_amdgcn_readfirstlane(threadIdx.x >> 6), lane = threadIdx.x & 63, fr = lane & 15, fq = lane >> 4;
    for (int job0 = blockIdx.x * 2; job0 < 512; job0 += gridDim.x * 2) {
        const int job = job0 + (wid >> 2), kq = wid & 3, rt = job & 7, ct = job >> 3;
        const bf16_t* a = A + (size_t)(rt * 16 + fr) * K + kq * KQ + fq * 8; const bf16_t* b = Bt + (size_t)(ct * 16 + fr) * K + kq * KQ + fq * 8;
        f32x4 acc = {0.f, 0.f, 0.f, 0.f};
#pragma unroll
        for (int h = 0; h < 2; ++h) {
            bf16x8 av[UN], bv[UN];
#pragma unroll
            for (int i = 0; i < UN; ++i) { av[i] = *(const bf16x8*)(a + (h * UN + i) * 32); bv[i] = *(const bf16x8*)(b + (h * UN + i) * 32); }
#pragma unroll
            for (int i = 0; i < UN; ++i) acc = __builtin_amdgcn_mfma_f32_16x16x32_bf16(av[i], bv[i], acc, 0, 0, 0);
        }
        __syncthreads();
        *(f32x4*)(red + (wid * 64 + lane) * 4) = acc;
        __syncthreads();
        if (kq == 0) {
            const f32x4 t01 = acc + *(const f32x4*)(red + ((wid + 1) * 64 + lane) * 4), t2 = *(const f32x4*)(red + ((wid + 2) * 64 + lane) * 4), t3 = *(const f32x4*)(red + ((wid + 3) * 64 + lane) * 4);
#pragma unroll
            for (int j = 0; j < 4; ++j) {
                const int r = rt * 16 + fq * 4 + j, c = ct * 16 + fr;
                float s2 = 1.f, s3 = 1.f;
                if (ssqy) { const f32x2 q = *(const f32x2*)(ssqy + (size_t)r * 2); s2 = frsq(q.x * (1.f / 512.f) + EPS); s3 = frsq(q.y * (1.f / 512.f) + EPS); }
                const float v = res[(size_t)r * DM + c] + t01[j] + s2 * t2[j] + s3 * t3[j];
                out[(size_t)r * DM + c] = v;
                if (outb) outb[(size_t)r * DM + c] = f2bf(v);
                float ss = v * v; ss += __shfl_xor(ss, 1); ss += __shfl_xor(ss, 2); ss += __shfl_xor(ss, 4); ss += __shfl_xor(ss, 8);
                if (fr == 0) atomicAdd(ssq + r, ss);
            }
        }
    }
}

DEV void transpose_weight(const float* __restrict__ src, bf16_t* __restrict__ dst, int K, int N, int Npad, int mode, const float* __restrict__ kscale, float* tile, int item) {
    constexpr int TS = 260;
    const int ntn = Npad / 256, kt = item / ntn, nt = item % ntn, k0 = kt * 64, n0 = nt * 256, tid = threadIdx.x;
    __syncthreads();
    f32x4 v[8];
#pragma unroll
    for (int i = 0; i < 8; ++i) {
        const int e = tid + i * 512, kk = e >> 6, n4 = (e & 63) * 4;
        int sc = n0 + n4;
        if (mode == 1) sc = n4 < 128 ? nt * 128 + n4 : DFF + nt * 128 + (n4 - 128);
        v[i] = (sc < N) ? *(const f32x4*)(src + (size_t)(k0 + kk) * N + sc) : (f32x4){0.f, 0.f, 0.f, 0.f};
        if (kscale) v[i] = v[i] * kscale[k0 + kk];
    }
#pragma unroll
    for (int i = 0; i < 8; ++i) { const int e = tid + i * 512, kk = e >> 6, n4 = (e & 63) * 4; *(f32x4*)(tile + kk * TS + n4) = v[i]; }
    __syncthreads();
#pragma unroll
    for (int i = 0; i < 4; ++i) {
        const int e = tid + i * 512, nn = e & 255, k8 = (e >> 8) * 8;
        u32x4 w;
        w.x = cvt_pk_bf16(tile[(k8 + 0) * TS + nn], tile[(k8 + 1) * TS + nn]); w.y = cvt_pk_bf16(tile[(k8 + 2) * TS + nn], tile[(k8 + 3) * TS + nn]);
        w.z = cvt_pk_bf16(tile[(k8 + 4) * TS + nn], tile[(k8 + 5) * TS + nn]); w.w = cvt_pk_bf16(tile[(k8 + 6) * TS + nn], tile[(k8 + 7) * TS + nn]);
        *(u32x4*)(dst + (size_t)(n0 + nn) * K + k0 + k8) = w;
    }
}

DEV void phase_prep(const Params& p, unsigned char* smem) {
    const int tid = threadIdx.x, gtid = blockIdx.x * 512 + tid, gsz = gridDim.x * 512;
    float* ssqy = (float*)(p.ws + W_SSQY);
    for (int i = gtid; i < (int)((W_LBV - W_SSQY) / 4); i += gsz) ssqy[i] = 0.f;
    float* lbv = (float*)(p.ws + W_LBV);
    for (int i = gtid; i < 1024; i += gsz) lbv[i] = sigmoidf_(p.hgrn_lb[i] - p.hgrn_lb[1024 + i]);
    bf16_t* wb_in = (bf16_t*)((unsigned char*)p.out + O_HS * 4 + (size_t)MT * 1024 * 2);
    float* tile = (float*)smem;
    const int n_in = 16 * (DINP / 256), n_out = 32 * 4, n_up = 16 * 22, n_down = 44 * 4;
    for (int it = blockIdx.x; it < n_in + n_out + n_up + n_down; it += gridDim.x) {
        if (it < n_in) transpose_weight(p.w_in, wb_in, 1024, DIN, DINP, 0, nullptr, tile, it);
        else if (it < n_in + n_out) transpose_weight(p.w_out, (bf16_t*)(p.ws + W_OUT), 2048, 1024, 1024, 0, nullptr, tile, it - n_in);
        else if (it < n_in + n_out + n_up) transpose_weight(p.w_up, (bf16_t*)(p.ws + W_UP), 1024, 5632, 5632, 1, p.norm2_w, tile, it - n_in - n_out);
        else transpose_weight(p.w_down, (bf16_t*)(p.ws + W_DOWN), 2816, 1024, 1024, 0, nullptr, tile, it - n_in - n_out - n_up);
    }
    bf16_t* h = (bf16_t*)((unsigned char*)p.out + O_HS * 4);
    const int wid = tid >> 6, lane = tid & 63;
    for (int row = blockIdx.x * 8 + wid; row < MT; row += gridDim.x * 8) {
        if (row >= MV) {
#pragma unroll
            for (int i = 0; i < 4; ++i) *(u32x2*)(h + (size_t)row * DM + i * 256 + lane * 4) = (u32x2){0u, 0u};
            continue;
        }
        const float* xr = row < NP ? p.x_prompt + (size_t)row * DM : p.x_sample + (size_t)(row - NP) * DM;
        f32x4 v[4]; float ss = 0.f;
#pragma unroll
        for (int i = 0; i < 4; ++i) { v[i] = *(const f32x4*)(xr + i * 256 + lane * 4); ss += v[i][0] * v[i][0] + v[i][1] * v[i][1] + v[i][2] * v[i][2] + v[i][3] * v[i][3]; }
#pragma unroll
        for (int o = 32; o >= 1; o >>= 1) ss += __shfl_xor(ss, o);
        const float rs = frsq(ss * (1.f / 1024.f) + EPS);
#pragma unroll
        for (int i = 0; i < 4; ++i) { const f32x4 w = *(const f32x4*)(p.norm1_w + i * 256 + lane * 4);
            u32x2 o; o.x = cvt_pk_bf16(v[i][0] * rs * w[0], v[i][1] * rs * w[1]); o.y = cvt_pk_bf16(v[i][2] * rs * w[2], v[i][3] * rs * w[3]);
            *(u32x2*)(h + (size_t)row * DM + i * 256 + lane * 4) = o; }
    }
}

#define LBAR() do { asm volatile("s_waitcnt lgkmcnt(0)" ::: "memory"); __builtin_amdgcn_s_barrier(); asm volatile("" ::: "memory"); } while (0)

DEV void phase_conv(const Params& p) {
    const bf16_t* proj = (const bf16_t*)(p.ws + W_PROJ);
    bf16_t* xc = (bf16_t*)(p.ws + W_XC);
    const int gtid = blockIdx.x * 512 + threadIdx.x, gsz = gridDim.x * 512;
    for (int it = gtid; it < 1024 * 192; it += gsz) {
        const int cg = it % 192, rb = it / 192, c0 = cg * 8, r0 = rb * 16;
        float w[4][8], bb[8], h0[8], h1[8], h2[8];
#pragma unroll
        for (int tap = 0; tap < 4; ++tap) { const f32x4 a = *(const f32x4*)(p.ssm_conv_w + tap * 1536 + c0), c = *(const f32x4*)(p.ssm_conv_w + tap * 1536 + c0 + 4);
#pragma unroll
            for (int j = 0; j < 4; ++j) { w[tap][j] = a[j]; w[tap][4 + j] = c[j]; } }
        { const f32x4 a = *(const f32x4*)(p.ssm_conv_b + c0), c = *(const f32x4*)(p.ssm_conv_b + c0 + 4);
#pragma unroll
          for (int j = 0; j < 4; ++j) { bb[j] = a[j]; bb[4 + j] = c[j]; } }
        const bool first = (r0 & (SEQ - 1)) == 0;
        const bf16_t* src = proj + (size_t)r0 * LDP + 3072 + c0;
        bf16x8 p0 = {0, 0, 0, 0, 0, 0, 0, 0}, p1 = p0, p2 = p0;
        if (!first) { p0 = *(const bf16x8*)(src - 3 * LDP); p1 = *(const bf16x8*)(src - 2 * LDP); p2 = *(const bf16x8*)(src - LDP); }
#pragma unroll
        for (int j = 0; j < 8; ++j) { h0[j] = bf2f((bf16_t)p0[j]); h1[j] = bf2f((bf16_t)p1[j]); h2[j] = bf2f((bf16_t)p2[j]); }
#pragma unroll 4
        for (int i = 0; i < 16; ++i) {
            const bf16x8 cv = *(const bf16x8*)(src + (size_t)i * LDP);
            float o[8];
#pragma unroll
            for (int j = 0; j < 8; ++j) { const float cur = bf2f((bf16_t)cv[j]); o[j] = siluf_(bb[j] + w[0][j] * h0[j] + w[1][j] * h1[j] + w[2][j] * h2[j] + w[3][j] * cur); h0[j] = h1[j]; h1[j] = h2[j]; h2[j] = cur; }
            u32x4 wv; wv.x = cvt_pk_bf16(o[0], o[1]); wv.y = cvt_pk_bf16(o[2], o[3]); wv.z = cvt_pk_bf16(o[4], o[5]); wv.w = cvt_pk_bf16(o[6], o[7]);
            *(u32x4*)(xc + (size_t)(r0 + i) * 1536 + c0) = wv;
        }
    }
    const float* dtb = (const float*)(p.ws + W_DTB); float* dtv = (float*)(p.ws + W_DTV);
    for (int i = gtid; i < NP * 16; i += gsz) { const int h = i & 15; const float dt = softplusf_(dtb[i] + p.ssm_dt_bias[h]);
        *(f32x2*)(dtv + (size_t)i * 2) = (f32x2){dt, -__expf(p.ssm_a_log[h]) * LOG2E * dt}; }
}

DEV void hgrn_prompt_item(const Params& p, int b, int hh, unsigned char* smem) {
    constexpr int LQ = 136, LS = 72;
    bf16_t* Q = (bf16_t*)smem;
    bf16_t* KT = Q + 64 * LQ;
    bf16_t* KH = KT + 64 * LQ;
    bf16_t* VT = KH + 128 * LS;
    bf16_t* PM = VT + 128 * LS;
    bf16_t* ST = PM + 64 * LS;
    bf16_t* OUT = ST + 128 * LQ;
    float* DV = (float*)(OUT + 64 * LQ);
    float* TOT = DV + 128;
    float* RS = TOT + 8 * 128;
    const int tid = threadIdx.x, wid = __builtin_amdgcn_readfirstlane(tid >> 6), lane0 = tid & 63;
    const bf16_t* proj = (const bf16_t*)(p.ws + W_PROJ);
    bf16_t* mix = (bf16_t*)p.out;
    __syncthreads();
    for (int i = tid; i < 128 * LQ / 2; i += 512) ((unsigned*)ST)[i] = 0u;
    f32x4 S[8];
#pragma unroll
    for (int i = 0; i < 8; ++i) S[i] = (f32x4){0.f, 0.f, 0.f, 0.f};
    int lane = lane0, fr = lane & 15, fq = lane >> 4;
    unsigned gq[8], qq[8]; bf16x8 va, vb; u32x4 ga[2];
#define HG_LOAD(cc) do { const size_t _r0 = (size_t)b * SEQ + (cc) * 64; \
        _Pragma("unroll") for (int i = 0; i < 8; ++i) { const bf16_t* pr = proj + (_r0 + wid * 8 + i) * LDP + hh * 128 + lane * 2; gq[i] = *(const unsigned*)(pr + 1024); qq[i] = *(const unsigned*)pr; } \
        { const bf16_t* pv = proj + (_r0 + lane) * LDP + 2048 + hh * 128 + wid * 16; va = *(const bf16x8*)pv; vb = *(const bf16x8*)(pv + 8); } \
        _Pragma("unroll") for (int i = 0; i < 2; ++i) { const int idx = tid + 512 * i; ga[i] = *(const u32x4*)(mix + (_r0 + (idx >> 4)) * LDM + hh * 128 + (idx & 15) * 8); } } while (0)
    HG_LOAD(0);
    float wnv[4];
#pragma unroll
    for (int x = 0; x < 4; ++x) wnv[x] = p.hgrn_norm_w[((wid >> 2) * 4 + x) * 16 + (lane0 & 15)];
    for (int c = 0; c < 32; ++c) {
        lane = lane0; asm volatile("" : "+v"(lane));
        fr = lane & 15; fq = lane >> 4;
        const int kp = lane * 2;
        const size_t r0 = (size_t)b * SEQ + c * 64;
        float g0[8], g1[8], q0[8], q1[8], kk0[8], kk1[8];
#pragma unroll
        for (int i = 0; i < 8; ++i) {
            g0[i] = __uint_as_float(gq[i] << 16); g1[i] = __uint_as_float(gq[i] & 0xffff0000u);
            q0[i] = __uint_as_float(qq[i] << 16); q1[i] = __uint_as_float(qq[i] & 0xffff0000u);
            kk0[i] = 1.f - fexp2(g0[i]); kk1[i] = 1.f - fexp2(g1[i]);
        }
#pragma unroll
        for (int i = 1; i < 8; ++i) { g0[i] += g0[i - 1]; g1[i] += g1[i - 1]; }
        *(f32x2*)(TOT + wid * 128 + kp) = (f32x2){g0[7], g1[7]};
        {
            const int s = lane, v0 = wid * 16;
#pragma unroll
            for (int j = 0; j < 8; ++j) { VT[(v0 + j) * LS + s] = (bf16_t)va[j]; VT[(v0 + 8 + j) * LS + s] = (bf16_t)vb[j]; }
        }
        LBAR();
        if (c > 0) {
#pragma unroll
            for (int i = 0; i < 2; ++i) { const int idx = tid + 512 * i, t = idx >> 4, v8 = (idx & 15) * 8;
                *(u32x4*)(mix + (r0 - 64 + t) * LDM + hh * 128 + v8) = *(const u32x4*)(OUT + t * LQ + v8); }
        }
        {
            float pre0 = 0.f, pre1 = 0.f, tot0 = 0.f, tot1 = 0.f;
#pragma unroll
            for (int w = 0; w < 8; ++w) { const f32x2 t = *(const f32x2*)(TOT + w * 128 + kp); if (w < wid) { pre0 += t.x; pre1 += t.y; } tot0 += t.x; tot1 += t.y; }
            if (wid == 0) *(f32x2*)(DV + kp) = (f32x2){fexp2(tot0), fexp2(tot1)};
            const float dv0 = fexp2(tot0), dv1 = fexp2(tot1);
            float h0[8], h1[8];
#pragma unroll
            for (int i = 0; i < 8; ++i) {
                const int t = wid * 8 + i;
                const float b0 = g0[i] + pre0, b1 = g1[i] + pre1;
                const float e0 = fexp2(b0), e1 = fexp2(b1), n0 = fexp2(-b0), n1 = fexp2(-b1);
                *(unsigned*)(Q + t * LQ + kp) = cvt_pk_bf16(q0[i] * e0, q1[i] * e1);
                *(unsigned*)(KT + t * LQ + kp) = cvt_pk_bf16(kk0[i] * n0, kk1[i] * n1);
                h0[i] = kk0[i] * n0 * dv0; h1[i] = kk1[i] * n1 * dv1;
            }
            {
                u32x4 w0, w1;
                w0.x = cvt_pk_bf16(h0[0], h0[1]); w0.y = cvt_pk_bf16(h0[2], h0[3]); w0.z = cvt_pk_bf16(h0[4], h0[5]); w0.w = cvt_pk_bf16(h0[6], h0[7]);
                w1.x = cvt_pk_bf16(h1[0], h1[1]); w1.y = cvt_pk_bf16(h1[2], h1[3]); w1.z = cvt_pk_bf16(h1[4], h1[5]); w1.w = cvt_pk_bf16(h1[6], h1[7]);
                *(u32x4*)(KH + kp * LS + wid * 8) = w0; *(u32x4*)(KH + (kp + 1) * LS + wid * 8) = w1;
            }
        }
        LBAR();
#pragma unroll
        for (int i = 0; i < 2; ++i) { const int idx = tid + 512 * i; *(u32x4*)(OUT + (idx >> 4) * LQ + (idx & 15) * 8) = ga[i]; }
        if (c < 31) HG_LOAD(c + 1);
        {
            const int ti = wid >> 1;
#pragma unroll
            for (int x = 0; x < 2; ++x) {
                const int si = (wid & 1) * 2 + x;
                f32x4 a = {0.f, 0.f, 0.f, 0.f};
                if (si <= ti) mma16(a, Q + ti * 16 * LQ, LQ, KT + si * 16 * LQ, LQ, 128, fr, fq);
#pragma unroll
                for (int j = 0; j < 4; ++j) { const int t = ti * 16 + fq * 4 + j, s = si * 16 + fr; PM[t * LS + s] = f2bf(s <= t ? a[j] : 0.f); }
            }
        }
        f32x4 o[4];
        const int oti = wid & 3, ovb = (wid >> 2) * 4;
#pragma unroll
        for (int x = 0; x < 4; ++x) { o[x] = (f32x4){0.f, 0.f, 0.f, 0.f}; mma16(o[x], Q + oti * 16 * LQ, LQ, ST + (ovb + x) * 16 * LQ, LQ, 128, fr, fq); }
        LBAR();
        float rsum[4] = {0.f, 0.f, 0.f, 0.f};
#pragma unroll
        for (int x = 0; x < 4; ++x) { mma16(o[x], PM + oti * 16 * LS, LS, VT + (ovb + x) * 16 * LS, LS, 64, fr, fq);
#pragma unroll
            for (int j = 0; j < 4; ++j) rsum[j] += o[x][j] * o[x][j]; }
#pragma unroll
        for (int j = 0; j < 4; ++j) { float r = rsum[j]; r += __shfl_xor(r, 1); r += __shfl_xor(r, 2); r += __shfl_xor(r, 4); r += __shfl_xor(r, 8); if (fr == 0) RS[(wid >> 2) * 64 + oti * 16 + fq * 4 + j] = r; }
        {
            const f32x4 dv = *(const f32x4*)(DV + wid * 16 + fq * 4);
#pragma unroll
            for (int x = 0; x < 8; ++x) {
                S[x] = S[x] * dv;
                mma16(S[x], KH + wid * 16 * LS, LS, VT + x * 16 * LS, LS, 64, fr, fq);
                u32x2 w; w.x = cvt_pk_bf16(S[x][0], S[x][1]); w.y = cvt_pk_bf16(S[x][2], S[x][3]);
                *(u32x2*)(ST + (x * 16 + fr) * LQ + wid * 16 + fq * 4) = w;
            }
        }
        LBAR();
#pragma unroll
        for (int j = 0; j < 4; ++j) {
            const int t = oti * 16 + fq * 4 + j;
            const float rstd = frsq((RS[t] + RS[64 + t]) * (1.f / 128.f) + EPS);
#pragma unroll
            for (int x = 0; x < 4; ++x) {
                const int v = (ovb + x) * 16 + fr;
                bf16_t* op = OUT + t * LQ + v;
                *op = f2bf(o[x][j] * rstd * wnv[x] * bf2f(*op));
            }
        }
    }
#undef HG_LOAD
    LBAR();
    {
        const size_t r0 = (size_t)b * SEQ + 31 * 64;
#pragma unroll
        for (int i = 0; i < 2; ++i) { const int idx = tid + 512 * i, t = idx >> 4, v8 = (idx & 15) * 8;
            *(u32x4*)(mix + (r0 + t) * LDM + hh * 128 + v8) = *(const u32x4*)(OUT + t * LQ + v8); }
    }
    float* hp = p.out + O_HP + ((size_t)(b * 8 + hh)) * 128 * 128;
#pragma unroll
    for (int x = 0; x < 8; ++x)
#pragma unroll
        for (int j = 0; j < 4; ++j) hp[(size_t)(wid * 16 + fq * 4 + j) * 128 + x * 16 + fr] = S[x][j];
}

DEV void ssd_prompt_item(const Params& p, int b, int hh, unsigned char* smem) {
    constexpr int LN_ = 136, LS = 72;
    bf16_t* XD = (bf16_t*)smem;
    bf16_t* XE = XD + 64 * LS;
    bf16_t* XN = XE + 64 * LS;
    bf16_t* ZG = XN + 64 * LS;
    bf16_t* OUT = ZG + 64 * LS;
    bf16_t* BN = OUT + 64 * LS;
    bf16_t* BT = BN + 64 * LN_;
    bf16_t* CN = BT + 128 * LS;
    bf16_t* MM = CN + 64 * LN_;
    bf16_t* SB = MM + 64 * LS;
    float* ACS = (float*)(SB + 64 * LN_);
    const int tid = threadIdx.x, wid = __builtin_amdgcn_readfirstlane(tid >> 6), lane0 = tid & 63;
    int lane = lane0, fr = lane & 15, fq = lane >> 4;
    const int grp = hh >> 3;
    const bf16_t* proj = (const bf16_t*)(p.ws + W_PROJ);
    const bf16_t* xc = (const bf16_t*)(p.ws + W_XC);
    const float* dtv = (const float*)(p.ws + W_DTV);
    float* ssqy = (float*)(p.ws + W_SSQY);
    bf16_t* mix = (bf16_t*)p.out;
    __syncthreads();
    for (int i = tid; i < 64 * LN_ / 2; i += 512) ((unsigned*)SB)[i] = 0u;
    f32x4 S[4];
#pragma unroll
    for (int i = 0; i < 4; ++i) S[i] = (f32x4){0.f, 0.f, 0.f, 0.f};
    const float Dh = p.ssm_d[hh];
    bf16x8 xr, br[2], cr[2]; u32x4 zr; f32x2 dta;
#define SS_LOAD(cc) do { const size_t _r0 = (size_t)b * SEQ + (cc) * 64; \
        xr = *(const bf16x8*)(xc + (_r0 + lane) * 1536 + hh * 64 + wid * 8); \
        zr = *(const u32x4*)(mix + (_r0 + lane) * LDM + 1024 + hh * 64 + wid * 8); \
        _Pragma("unroll") for (int i = 0; i < 2; ++i) { const bf16_t* pb = xc + (_r0 + lane) * 1536 + 1024 + grp * 128 + (wid + 8 * i) * 8; \
            br[i] = *(const bf16x8*)pb; cr[i] = *(const bf16x8*)(pb + 256); } \
        dta = *(const f32x2*)(dtv + ((_r0 + lane) * 16 + hh) * 2); } while (0)
    SS_LOAD(0);
    float wnv[2];
#pragma unroll
    for (int x = 0; x < 2; ++x) wnv[x] = p.ssm_norm_w[hh * 64 + ((wid >> 2) * 2 + x) * 16 + (lane0 & 15)];
    for (int c = 0; c < 32; ++c) {
        lane = lane0; asm volatile("" : "+v"(lane));
        fr = lane & 15; fq = lane >> 4;
        const size_t r0 = (size_t)b * SEQ + c * 64;
        const float dt = dta.x;
        float acs = dta.y;
#pragma unroll
        for (int o = 1; o < 64; o <<= 1) { const float u = __shfl_up(acs, o); if (lane >= o) acs += u; }
        const float alast = __shfl(acs, 63);
        if (wid == 0) ACS[lane] = acs;
        const float decl = fexp2(alast - acs);
        {
            const int tx = lane, p8 = wid * 8;
            const float dtx = dt, dex = decl * dt;
            *(bf16x8*)(XN + tx * LS + p8) = xr; *(u32x4*)(ZG + tx * LS + p8) = zr;
#pragma unroll
            for (int j = 0; j < 8; ++j) { const float xv = bf2f((bf16_t)xr[j]); XD[(p8 + j) * LS + tx] = f2bf(xv * dtx); XE[(p8 + j) * LS + tx] = f2bf(xv * dex); }
#pragma unroll
            for (int i = 0; i < 2; ++i) { const int t = lane, n8 = (wid + 8 * i) * 8;
                *(bf16x8*)(BN + t * LN_ + n8) = br[i]; *(bf16x8*)(CN + t * LN_ + n8) = cr[i];
#pragma unroll
                for (int j = 0; j < 8; ++j) BT[(n8 + j) * LS + t] = (bf16_t)br[i][j]; }
        }
        if (c < 31) SS_LOAD(c + 1);
        LBAR();
        {
            const int ti = wid >> 1;
#pragma unroll
            for (int x = 0; x < 2; ++x) {
                const int si = (wid & 1) * 2 + x;
                f32x4 a = {0.f, 0.f, 0.f, 0.f};
                if (si <= ti) mma16(a, CN + ti * 16 * LN_, LN_, BN + si * 16 * LN_, LN_, 128, fr, fq);
                const float as = ACS[si * 16 + fr];
#pragma unroll
                for (int j = 0; j < 4; ++j) { const int tt = ti * 16 + fq * 4 + j, s = si * 16 + fr; MM[tt * LS + s] = f2bf(s <= tt ? a[j] * fexp2(ACS[tt] - as) : 0.f); }
            }
        }
        f32x4 y[2];
        const int yti = wid & 3, ypb = (wid >> 2) * 2;
#pragma unroll
        for (int x = 0; x < 2; ++x) { y[x] = (f32x4){0.f, 0.f, 0.f, 0.f}; mma16(y[x], CN + yti * 16 * LN_, LN_, SB + (ypb + x) * 16 * LN_, LN_, 128, fr, fq);
#pragma unroll
            for (int j = 0; j < 4; ++j) y[x][j] *= fexp2(ACS[yti * 16 + fq * 4 + j]); }
        LBAR();
        float rsum[4] = {0.f, 0.f, 0.f, 0.f};
#pragma unroll
        for (int x = 0; x < 2; ++x) {
            mma16(y[x], MM + yti * 16 * LS, LS, XD + (ypb + x) * 16 * LS, LS, 64, fr, fq);
            const int pp = (ypb + x) * 16 + fr;
            const float wn = wnv[x];
#pragma unroll
            for (int j = 0; j < 4; ++j) {
                const int tt = yti * 16 + fq * 4 + j;
                const float yv = (y[x][j] + Dh * bf2f(XN[tt * LS + pp])) * bf2f(ZG[tt * LS + pp]);
                rsum[j] += yv * yv;
                OUT[tt * LS + pp] = f2bf(yv * wn);
            }
        }
#pragma unroll
        for (int j = 0; j < 4; ++j) { float r = rsum[j]; r += __shfl_xor(r, 1); r += __shfl_xor(r, 2); r += __shfl_xor(r, 4); r += __shfl_xor(r, 8);
            if (fr == 0) atomicAdd(ssqy + (r0 + yti * 16 + fq * 4 + j) * 2 + grp, r); }
        {
            const float dl = fexp2(alast);
            const int pt = wid & 3, nb = (wid >> 2) * 4;
#pragma unroll
            for (int x = 0; x < 4; ++x) {
                S[x] = S[x] * dl;
                mma16(S[x], XE + pt * 16 * LS, LS, BT + (nb + x) * 16 * LS, LS, 64, fr, fq);
#pragma unroll
                for (int j = 0; j < 4; ++j) SB[(pt * 16 + fq * 4 + j) * LN_ + (nb + x) * 16 + fr] = f2bf(S[x][j]);
            }
        }
        LBAR();
        { const int tx = tid >> 3, p8 = (tid & 7) * 8; *(u32x4*)(mix + (r0 + tx) * LDM + 1024 + hh * 64 + p8) = *(const u32x4*)(OUT + tx * LS + p8); }
    }
#undef SS_LOAD
    {
        float* sp = p.out + O_SP + ((size_t)(b * 16 + hh)) * 64 * 128;
        const int pt = wid & 3, nb = (wid >> 2) * 4;
#pragma unroll
        for (int x = 0; x < 4; ++x)
#pragma unroll
            for (int j = 0; j < 4; ++j) sp[(size_t)(pt * 16 + fq * 4 + j) * 128 + (nb + x) * 16 + fr] = S[x][j];
    }
    if (tid < 288) { const int j = tid / 96, cc = hh * 96 + tid % 96;
        p.out[O_CSP + ((size_t)b * 3 + j) * 1536 + cc] = bf2f(proj[((size_t)b * SEQ + 2045 + j) * LDP + 3072 + cc]); }
}

DEV void hgrn_sample_item(const Params& p, int b, int hh, unsigned char* smem) {
    float* qv = (float*)smem; float* fv = qv + 128; float* kv = fv + 128; float* vv = kv + 128; float* red = vv + 128; float* sc = red + 16 * 128;
    const int tid = threadIdx.x;
    const size_t row = NP + b;
    const bf16_t* pr = (const bf16_t*)(p.ws + W_PROJ) + row * LDP + hh * 128;
    bf16_t* mix = (bf16_t*)p.out + row * LDM + hh * 128;
    const int v4 = tid & 31, kq = tid >> 5;
    const float* Sin = p.st_hgrn + ((size_t)(b * 8 + hh)) * 16384; float* Sout = p.out + O_HS + ((size_t)(b * 8 + hh)) * 16384;
    f32x4 sreg[8];
#pragma unroll
    for (int i = 0; i < 8; ++i) sreg[i] = *(const f32x4*)(Sin + (kq * 8 + i) * 128 + v4 * 4);
    float pq_ = 0.f, pg_ = 0.f, pv_ = 0.f;
    if (tid < 128) { pq_ = bf2f(pr[tid]); pg_ = bf2f(pr[1024 + tid]); pv_ = bf2f(pr[2048 + tid]); }
    __syncthreads();
    if (tid < 128) { const float f = fexp2(pg_); qv[tid] = pq_; fv[tid] = f; kv[tid] = 1.f - f; vv[tid] = pv_; }
    __syncthreads();
    const f32x4 vx = *(const f32x4*)(vv + v4 * 4);
    f32x4 acc = {0.f, 0.f, 0.f, 0.f};
#pragma unroll
    for (int i = 0; i < 8; ++i) { const int k = kq * 8 + i; const f32x4 sn = sreg[i] * fv[k] + vx * kv[k];
        *(f32x4*)(Sout + k * 128 + v4 * 4) = sn; acc += sn * qv[k]; }
    *(f32x4*)(red + kq * 128 + v4 * 4) = acc;
    __syncthreads();
    float o = 0.f;
    if (tid < 128) {
#pragma unroll
        for (int i = 0; i < 16; ++i) o += red[i * 128 + tid];
        float ss = o * o;
#pragma unroll
        for (int x = 32; x >= 1; x >>= 1) ss += __shfl_xor(ss, x);
        if ((tid & 63) == 0) sc[tid >> 6] = ss;
    }
    __syncthreads();
    if (tid < 128) { const float rstd = frsq((sc[0] + sc[1]) * (1.f / 128.f) + EPS); mix[tid] = f2bf(o * rstd * p.hgrn_norm_w[tid] * bf2f(mix[tid])); }
}

DEV void ssd_sample_item(const Params& p, int b, int hh, unsigned char* smem) {
    float* xs = (float*)smem; float* Bv = xs + 64; float* Cv = Bv + 128; float* yv = Cv + 128;
    const int tid = threadIdx.x, grp = hh >> 3;
    const size_t row = NP + b;
    const bf16_t* pr = (const bf16_t*)(p.ws + W_PROJ) + row * LDP + 3072;
    const float* st = p.st_cs + (size_t)b * 3 * 1536;
    bf16_t* mix = (bf16_t*)p.out + row * LDM + 1024 + hh * 64;
    const int n4 = tid & 31, pq = tid >> 5;
    const float* Sin = p.st_ssm + ((size_t)(b * 16 + hh)) * 8192; float* Sout = p.out + O_SS + ((size_t)(b * 16 + hh)) * 8192;
    f32x4 sreg[4];
#pragma unroll
    for (int i = 0; i < 4; ++i) sreg[i] = *(const f32x4*)(Sin + (pq * 4 + i) * 128 + n4 * 4);
    __syncthreads();
    if (tid < 320) {
        const int cc = tid < 64 ? hh * 64 + tid : (tid < 192 ? 1024 + grp * 128 + (tid - 64) : 1280 + grp * 128 + (tid - 192));
        float a = p.ssm_conv_b[cc] + p.ssm_conv_w[cc] * st[cc] + p.ssm_conv_w[1536 + cc] * st[1536 + cc] + p.ssm_conv_w[3072 + cc] * st[3072 + cc] + p.ssm_conv_w[4608 + cc] * bf2f(pr[cc]);
        a = siluf_(a);
        if (tid < 64) xs[tid] = a; else if (tid < 192) Bv[tid - 64] = a; else Cv[tid - 192] = a;
    }
    if (tid >= 384 && tid < 480) { const int cc = hh * 96 + (tid - 384);
        float* o = p.out + O_CSS + (size_t)b * 3 * 1536; o[cc] = st[1536 + cc]; o[1536 + cc] = st[3072 + cc]; o[3072 + cc] = bf2f(pr[cc]); }
    __syncthreads();
    const float dt = softplusf_(((const float*)(p.ws + W_DTB))[row * 16 + hh] + p.ssm_dt_bias[hh]);
    const float dA = __expf(-__expf(p.ssm_a_log[hh]) * dt), Dh = p.ssm_d[hh];
    const f32x4 Bx = *(const f32x4*)(Bv + n4 * 4), Cx = *(const f32x4*)(Cv + n4 * 4);
#pragma unroll
    for (int i = 0; i < 4; ++i) {
        const int pp = pq * 4 + i; const float xd = xs[pp] * dt;
        const f32x4 sn = sreg[i] * dA + Bx * xd;
        *(f32x4*)(Sout + pp * 128 + n4 * 4) = sn;
        float part = sn[0] * Cx[0] + sn[1] * Cx[1] + sn[2] * Cx[2] + sn[3] * Cx[3];
#pragma unroll
        for (int x = 16; x >= 1; x >>= 1) part += __shfl_xor(part, x);
        if (n4 == 0) yv[pp] = part + Dh * xs[pp];
    }
    __syncthreads();
    if (tid < 64) {
        const float y = yv[tid] * bf2f(mix[tid]);
        float ss = y * y;
#pragma unroll
        for (int x = 32; x >= 1; x >>= 1) ss += __shfl_xor(ss, x);
        if (tid == 0) atomicAdd((float*)(p.ws + W_SSQY) + row * 2 + grp, ss);
        mix[tid] = f2bf(y * p.ssm_norm_w[hh * 64 + tid]);
    }
}

DEV void phase_scan(const Params& p, unsigned char* smem) {
    for (int it = blockIdx.x; it < 192; it += gridDim.x) {
        if (it < 64) hgrn_prompt_item(p, it >> 3, it & 7, smem);
        else ssd_prompt_item(p, (it - 64) >> 4, (it - 64) & 15, smem);
    }
    unsigned* ctr = (unsigned*)(p.ws + W_CTR);
    LAS unsigned* slot = (LAS unsigned*)(smem + LDS_BYTES - 16);
    for (;;) {
        __syncthreads();
        if (threadIdx.x == 0) *slot = atomicAdd(ctr, 1u);
        __syncthreads();
        const unsigned j = *slot;
        if (j >= 3072u) break;
        if (j < 1024u) hgrn_sample_item(p, j >> 3, j & 7, smem);
        else ssd_sample_item(p, (j - 1024u) >> 4, (j - 1024u) & 15, smem);
    }
}

DEV void phase_yscale(const Params& p) {
    bf16_t* mix = (bf16_t*)p.out; const float* ssqy = (const float*)(p.ws + W_SSQY);
    const int gsz = gridDim.x * 512;
    for (int i0 = blockIdx.x * 512 + threadIdx.x; i0 < MV * 128; i0 += gsz * 4) {
        u32x4 w[4]; float rs[4];
#pragma unroll
        for (int u = 0; u < 4; ++u) { const int i = i0 + u * gsz; if (i < MV * 128) { const int row = i >> 7, c8 = i & 127;
            w[u] = *(const u32x4*)(mix + (size_t)row * LDM + 1024 + c8 * 8); rs[u] = ssqy[row * 2 + (c8 >> 6)]; } }
#pragma unroll
        for (int u = 0; u < 4; ++u) { const int i = i0 + u * gsz; if (i < MV * 128) { const int row = i >> 7, c8 = i & 127;
            const float r = frsq(rs[u] * (1.f / 512.f) + EPS);
            unsigned* ww = (unsigned*)&w[u];
#pragma unroll
            for (int j = 0; j < 4; ++j) ww[j] = cvt_pk_bf16(__uint_as_float(ww[j] << 16) * r, __uint_as_float(ww[j] & 0xffff0000u) * r);
            *(u32x4*)(mix + (size_t)row * LDM + 1024 + c8 * 8) = w[u]; } }
    }
}

DEV void fix_hmid_rows(const Params& p, int pm) {
    const float* T = (const float*)(p.ws + W_T); const float* Fg = (const float*)(p.ws + W_FG); const float* Fv = (const float*)(p.ws + W_FV);
    bf16_t* hmid = (bf16_t*)(p.ws + W_HMID);
    for (int ch = threadIdx.x; ch < DFF; ch += 512) {
        const bool first = (pm & 7) == 0;
        const float gm2 = first ? 0.f : T[((size_t)(pm - 1) * 2 + 0) * DFF + ch], gm1 = first ? 0.f : T[((size_t)(pm - 1) * 2 + 1) * DFF + ch];
        const float G0 = Fg[((size_t)pm * 2 + 0) * DFF + ch], G1 = Fg[((size_t)pm * 2 + 1) * DFF + ch];
        const float v0 = Fv[((size_t)pm * 2 + 0) * DFF + ch], v1 = Fv[((size_t)pm * 2 + 1) * DFF + ch];
        const float w0 = p.ffn_conv_w[ch], w1 = p.ffn_conv_w[DFF + ch], w2 = p.ffn_conv_w[2 * DFF + ch], bb = p.ffn_conv_b[ch];
        hmid[(size_t)(pm * 256) * DFF + ch] = f2bf(siluf_(bb + w0 * gm2 + w1 * gm1 + w2 * G0) * v0);
        hmid[(size_t)(pm * 256 + 1) * DFF + ch] = f2bf(siluf_(bb + w0 * gm1 + w1 * G0 + w2 * G1) * v1);
    }
}

DEV void phase_final(const Params& p) {
    const float* ssq3 = (const float*)(p.ws + W_SSQ3);
    const int wid = threadIdx.x >> 6, lane = threadIdx.x & 63, wstride = gridDim.x * 8;
    f32x4 w[4];
#pragma unroll
    for (int i = 0; i < 4; ++i) w[i] = *(const f32x4*)(p.final_norm_w + i * 256 + lane * 4);
    for (int row0 = blockIdx.x * 8 + wid; row0 < MV; row0 += wstride * 4) {
        f32x4 v[4][4]; float rs[4];
#pragma unroll
        for (int u = 0; u < 4; ++u) { const int row = row0 + u * wstride; if (row < MV) { rs[u] = ssq3[row];
#pragma unroll
            for (int i = 0; i < 4; ++i) v[u][i] = *(const f32x4*)(p.out + (size_t)row * DM + i * 256 + lane * 4); } }
#pragma unroll
        for (int u = 0; u < 4; ++u) { const int row = row0 + u * wstride; if (row < MV) { const float r = frsq(rs[u] * (1.f / 1024.f) + EPS);
#pragma unroll
            for (int i = 0; i < 4; ++i) *(f32x4*)(p.out + (size_t)row * DM + i * 256 + lane * 4) = v[u][i] * w[i] * r; } }
    }
}

__global__ void __launch_bounds__(512, 2) hymba_fwd(Params p) {
    extern __shared__ __attribute__((aligned(16))) unsigned char smem[];
    cg::grid_group grid = cg::this_grid();
    LAS unsigned char* lds = (LAS unsigned char*)smem;
    bf16_t* h = (bf16_t*)((unsigned char*)p.out + O_HS * 4);
    bf16_t* wb_in = h + (size_t)MT * 1024;
    bf16_t* mix = (bf16_t*)p.out;
#define PHASE_BEGIN(k) if (p.phase_lo <= (k) && (k) < p.phase_hi) { if ((k) != p.phase_lo) grid.sync();
#define PHASE_END }
    PHASE_BEGIN(0) phase_prep(p, smem); PHASE_END
    PHASE_BEGIN(1)
        pg8::StaticOrder S; S.init(MT, DINP, gridDim.x, blockIdx.x);
        EpiIn E{(bf16_t*)(p.ws + W_PROJ), mix, (float*)(p.ws + W_DTB), (const float*)(p.ws + W_LBV)};
        pg8::gemm_phase(lds, pg8::Gemm{h, wb_in, MT, DINP, 1024}, S, E);
    PHASE_END
    PHASE_BEGIN(2) phase_conv(p); PHASE_END
    PHASE_BEGIN(3) phase_scan(p, smem); PHASE_END
    PHASE_BEGIN(4)
        pg8::StaticOrder S; S.init(NP, 1024, gridDim.x, blockIdx.x);
        EpiRes<true> E{p.x_prompt, p.x_sample, (float*)(p.ws + W_X1), (bf16_t*)(p.ws + W_X1B), (float*)(p.ws + W_SSQ2), (const float*)(p.ws + W_SSQY)};
        pg8::gemm_phase(lds, pg8::Gemm{mix, (const bf16_t*)(p.ws + W_OUT), NP, 1024, 2048}, S, E);
        sample_gemm_res<2048>(mix + (size_t)NP * LDM, (const bf16_t*)(p.ws + W_OUT), p.x_sample, (float*)(p.ws + W_X1) + (size_t)NP * DM,
                        (bf16_t*)(p.ws + W_X1B) + (size_t)NP * DM, (float*)(p.ws + W_SSQ2) + NP, (float*)smem, (const float*)(p.ws + W_SSQY) + (size_t)NP * 2);
    PHASE_END
    PHASE_BEGIN(5)
        pg8::StaticOrder S; S.init(MT, 5632, gridDim.x, blockIdx.x);
        EpiUp E{(bf16_t*)(p.ws + W_HMID), (const float*)(p.ws + W_SSQ2), p.ffn_conv_w, p.ffn_conv_b, (float*)(p.ws + W_T), (float*)(p.ws + W_FG), (float*)(p.ws + W_FV),
                p.st_cf, p.out + O_CFP, p.out + O_CFS, (LAS float*)(lds + 131072)};
        pg8::gemm_phase(lds, pg8::Gemm{(const bf16_t*)(p.ws + W_X1B), (const bf16_t*)(p.ws + W_UP), MT, 5632, 1024}, S, E);
    PHASE_END
    PHASE_BEGIN(6)
        pg8::StaticOrder S; S.init(NP, 1024, gridDim.x, blockIdx.x);
        { Unit u; for (int i = 0; S.next(i, u); ++i) fix_hmid_rows(p, u.pm); }
        __builtin_amdgcn_fence(__ATOMIC_SEQ_CST, "agent");
        __syncthreads();
        const float* x1 = (const float*)(p.ws + W_X1);
        EpiRes<false> E{x1, x1 + (size_t)NP * DM, p.out, nullptr, (float*)(p.ws + W_SSQ3), nullptr};
        pg8::gemm_phase(lds, pg8::Gemm{(const bf16_t*)(p.ws + W_HMID), (const bf16_t*)(p.ws + W_DOWN), NP, 1024, DFF}, S, E);
        sample_gemm_res<DFF>((const bf16_t*)(p.ws + W_HMID) + (size_t)NP * DFF, (const bf16_t*)(p.ws + W_DOWN), x1 + (size_t)NP * DM, p.out + (size_t)NP * DM,
                        nullptr, (float*)(p.ws + W_SSQ3) + NP, (float*)smem, nullptr);
    PHASE_END
    PHASE_BEGIN(7) phase_final(p); PHASE_END
}

extern "C" void kernel_launch(void* const* d_in, const int* in_sizes, int n_in, void* d_out, int out_size, void* d_ws, size_t ws_size, hipStream_t stream) {
    static int grid_blocks = 0;
    if (!grid_blocks) {
        int dev = 0, cus = 0, per_cu = 0;
        hipGetDevice(&dev);
        hipDeviceGetAttribute(&cus, hipDeviceAttributeMultiprocessorCount, dev);
        hipFuncSetAttribute((const void*)hymba_fwd, hipFuncAttributeMaxDynamicSharedMemorySize, LDS_BYTES);
        hipOccupancyMaxActiveBlocksPerMultiprocessor(&per_cu, hymba_fwd, 512, LDS_BYTES);
        if (per_cu < 1) per_cu = 1;
        grid_blocks = cus * per_cu;
        if (grid_blocks > 256) grid_blocks = 256;
        if (ws_size < W_END) fprintf(stderr, "workspace too small: %zu < %zu\n", ws_size, (size_t)W_END);
    }
    Params p{};
    const float** f = (const float**)&p;
    for (int i = 0; i < 23; ++i) f[i] = (const float*)d_in[i];
    p.out = (float*)d_out; p.ws = (unsigned char*)d_ws;
#ifndef PROBE_HI
#define PROBE_HI 8
#endif
#ifndef MK_SPLIT
#define MK_SPLIT 0
#endif
#if MK_SPLIT
    for (int k = 0; k < PROBE_HI; ++k) {
        p.phase_lo = k; p.phase_hi = k + 1;
        hipLaunchKernelGGL(hymba_fwd, dim3(grid_blocks), dim3(512), LDS_BYTES, stream, p);
    }
    if (PROBE_HI == 2) {
        hipMemcpyAsync((float*)d_out + O_SS, (unsigned char*)d_ws + W_PROJ, (size_t)64 << 20, hipMemcpyDeviceToDevice, stream);
        hipMemcpyAsync((float*)d_out + O_SP, (unsigned char*)d_ws + W_DTB, (size_t)1 << 20, hipMemcpyDeviceToDevice, stream);
    }
#else
    p.phase_lo = 0; p.phase_hi = 8;
    void* args[] = {&p};
    hipError_t e = hipLaunchCooperativeKernel((const void*)hymba_fwd, dim3(grid_blocks), dim3(512), args, LDS_BYTES, stream);
    if (e != hipSuccess) fprintf(stderr, "cooperative launch failed: %s (grid %d)\n", hipGetErrorString(e), grid_blocks);
#endif
}
```
